# Optimizing an MI355X kernel written in HIP

```python
import math
import jax, jax.numpy as jnp
from jax import lax
import numpy as np

D_MODEL = 2048
BATCH = 8
SEQ = 2048
DEPTH = 2

GRID_W = 64
CTX_LEN = 256
HEAD_DIM = 128
ATT_HEADS = 6
ATT_KV_HEADS = 2
RET_HEADS = 4
RET_DK = 128
RET_DV = 128
SSD_HEADS = 12
SSD_HEAD_DIM = 64
SSD_GROUPS = 2
SSD_STATE = 128
SSD_CONV = 5
ATT_W = ATT_HEADS * HEAD_DIM
KV_W = ATT_KV_HEADS * HEAD_DIM
RET_QK_W = RET_HEADS * RET_DK
RET_W = RET_HEADS * RET_DV
SSD_W = SSD_HEADS * SSD_HEAD_DIM
SSD_BC = SSD_GROUPS * SSD_STATE
CONV_CH = SSD_W + 2 * SSD_BC
D_MIX = ATT_W + RET_W + SSD_W
IN_WIDTHS = (ATT_W, KV_W, KV_W, RET_QK_W, RET_QK_W, RET_W, RET_W, SSD_W, CONV_CH, SSD_HEADS, SSD_HEADS)
D_IN = sum(IN_WIDTHS)
D_FF = -(-8 * D_MODEL // (3 * 256)) * 256
CHUNK = 128
Q_BLOCK = 128
ROPE_THETA = 10000.0
EPS = 1e-6

kernel_name = "hybrid_attn_retention_ssd_dit_block"


def rmsnorm(x, g=None):
    xf = x.astype(jnp.float32)
    y = xf * lax.rsqrt(jnp.mean(xf * xf, axis=-1, keepdims=True) + EPS)
    if g is not None:
        y = y * g.astype(jnp.float32)
    return y.astype(x.dtype)


def axial_rope(rows):
    row = jnp.repeat(jnp.arange(rows, dtype=jnp.float32), GRID_W)
    col = jnp.tile(jnp.arange(GRID_W, dtype=jnp.float32), rows)
    n_freq = HEAD_DIM // 4
    inv = ROPE_THETA ** (-jnp.arange(n_freq, dtype=jnp.float32) / n_freq)
    ang = jnp.concatenate([row[:, None] * inv, col[:, None] * inv], axis=-1)
    return jnp.cos(ang), jnp.sin(ang)


def apply_rope(x, cos, sin):
    xf = x.astype(jnp.float32).reshape(*x.shape[:-1], -1, 2)
    x1, x2 = xf[..., 0], xf[..., 1]
    cs, sn = cos[None, :, None, :], sin[None, :, None, :]
    out = jnp.stack([x1 * cs - x2 * sn, x1 * sn + x2 * cs], axis=-1).reshape(x.shape)
    return out.astype(x.dtype)


def dwconv_centred(u, w, b):
    k = w.shape[0]
    out = lax.conv_general_dilated(u, w[:, None, :].astype(u.dtype), window_strides=(1,),
                                   padding=[(k // 2, k // 2)], dimension_numbers=('NWC', 'WIO', 'NWC'),
                                   feature_group_count=u.shape[-1])
    return out + b


def chunked_scan(q, k, v, log_a, s0):
    bsz, L, H, N = q.shape
    P = v.shape[-1]
    nc = L // CHUNK
    f32 = jnp.float32
    qc = q.reshape(bsz, nc, CHUNK, H, N).astype(f32)
    kc = k.reshape(bsz, nc, CHUNK, H, N).astype(f32)
    vc = v.reshape(bsz, nc, CHUNK, H, P).astype(f32)
    acs = jnp.cumsum(log_a.astype(f32).reshape(bsz, nc, CHUNK, H), axis=2)
    tri = jnp.tril(jnp.ones((CHUNK, CHUNK), dtype=bool))
    seg = acs[:, :, :, None, :] - acs[:, :, None, :, :]
    dmat = jnp.exp(jnp.where(tri[None, None, :, :, None], seg, -jnp.inf))
    scores = jnp.einsum('bcihn,bcjhn->bcijh', qc, kc) * dmat
    y_intra = jnp.einsum('bcijh,bcjhp->bcihp', scores, vc)
    decay_end = jnp.exp(acs[:, :, -1:, :] - acs)
    states = jnp.einsum('bcjhn,bcjh,bcjhp->cbhnp', kc, decay_end, vc)
    chunk_decay = jnp.exp(acs[:, :, -1, :]).transpose(1, 0, 2)

    def step(s, inp):
        st, dec = inp
        return s * dec[..., None, None] + st, s

    s_final, s_enter = lax.scan(step, s0.astype(f32), (states, chunk_decay))
    y_inter = jnp.einsum('bcihn,cbhnp,bcih->bcihp', qc, s_enter, jnp.exp(acs))
    return (y_intra + y_inter).reshape(bsz, L, H, P).astype(v.dtype), s_final


def bidir_scan(q, k_f, k_b, v, la_f, la_b, s0_f, s0_b):
    y_f, s_f = chunked_scan(q, k_f, v, la_f, s0_f)
    fl = lambda t: jnp.flip(t, axis=1)
    y_b, s_b = chunked_scan(fl(q), fl(k_b), fl(v), fl(la_b), s0_b)
    return y_f + fl(y_b), s_f, s_b


def block_attention(q, k, v):
    bsz, L, hq, dh = q.shape
    rep = hq // ATT_KV_HEADS
    nb = L // Q_BLOCK
    qb = q.reshape(bsz, nb, Q_BLOCK, ATT_KV_HEADS, rep, dh).transpose(1, 0, 2, 3, 4, 5)
    scale = HEAD_DIM ** -0.5

    def one_block(qi):
        s = jnp.einsum('bqgrd,bkgd->bgrqk', qi, k).astype(jnp.float32) * scale
        pr = jax.nn.softmax(s, axis=-1).astype(v.dtype)
        return jnp.einsum('bgrqk,bkgd->bqgrd', pr, v)

    out = lax.map(one_block, qb)
    return out.transpose(1, 0, 2, 3, 4, 5).reshape(bsz, L, hq * dh)


def token_tensors(h, p, rope):
    bsz, L, _ = h.shape
    splits = [int(s) for s in np.cumsum(IN_WIDTHS)[:-1]]
    aq, ak, av, rq, rk, rv, rg, z, xbc, dtf, dtb = jnp.split(h @ p['w_in'], splits, axis=-1)
    aq = rmsnorm(aq.reshape(bsz, L, ATT_HEADS, HEAD_DIM), p['q_norm_g'])
    ak = rmsnorm(ak.reshape(bsz, L, ATT_KV_HEADS, HEAD_DIM), p['k_norm_g'])
    av = av.reshape(bsz, L, ATT_KV_HEADS, HEAD_DIM)
    rq = rq.reshape(bsz, L, RET_HEADS, RET_DK)
    rk = rk.reshape(bsz, L, RET_HEADS, RET_DK) * (RET_DK ** -0.5)
    rv = rv.reshape(bsz, L, RET_HEADS, RET_DV)
    if rope is not None:
        cos, sin = rope
        aq, ak, rq, rk = (apply_rope(t, cos, sin) for t in (aq, ak, rq, rk))
    xbc = jax.nn.silu(dwconv_centred(xbc, p['conv_w'], p['conv_b']))
    xs, bs, cs = jnp.split(xbc, [SSD_W, SSD_W + SSD_BC], axis=-1)
    hpg = SSD_HEADS // SSD_GROUPS
    xs = xs.reshape(bsz, L, SSD_HEADS, SSD_HEAD_DIM)
    bs = jnp.repeat(bs.reshape(bsz, L, SSD_GROUPS, SSD_STATE), hpg, axis=2)
    cs = jnp.repeat(cs.reshape(bsz, L, SSD_GROUPS, SSD_STATE), hpg, axis=2)
    dt_f = jax.nn.softplus(dtf.astype(jnp.float32) + p['dt_bias_f'].astype(jnp.float32))
    dt_b = jax.nn.softplus(dtb.astype(jnp.float32) + p['dt_bias_b'].astype(jnp.float32))
    la_f = dt_f * -jnp.exp(p['a_log_f'].astype(jnp.float32))
    la_b = dt_b * -jnp.exp(p['a_log_b'].astype(jnp.float32))
    ret_lf = jnp.broadcast_to(jnp.log1p(-jnp.exp2(p['ret_decay_f'].astype(jnp.float32))), (bsz, L, RET_HEADS))
    ret_lb = jnp.broadcast_to(jnp.log1p(-jnp.exp2(p['ret_decay_b'].astype(jnp.float32))), (bsz, L, RET_HEADS))
    return dict(aq=aq, ak=ak, av=av, rq=rq, rk=rk, rv=rv, rg=rg, ret_lf=ret_lf, ret_lb=ret_lb,
                z=z, xs=xs, cs=cs, k_f=bs * dt_f[..., None].astype(bs.dtype),
                k_b=bs * dt_b[..., None].astype(bs.dtype), la_f=la_f, la_b=la_b)


def mixer_output(att, ret, ssd, t, p):
    bsz, L = att.shape[:2]
    ret = rmsnorm(ret).reshape(bsz, L, RET_W) * jax.nn.silu(t['rg'])
    ssd = (ssd + p['d_skip'][:, None] * t['xs']).reshape(bsz, L, SSD_W)
    ssd = rmsnorm(ssd * jax.nn.silu(t['z']), p['ssd_norm_g'])
    return jnp.concatenate([att, ret, ssd], axis=-1) @ p['w_out']


def swiglu(h, p):
    return (jax.nn.silu(h @ p['w_gate']) * (h @ p['w_up'])) @ p['w_down']


def hybrid_layer(x, xc, c, c_ctx, p, rope, last):
    bsz = x.shape[0]
    mod = jax.nn.silu(c) @ p['w_mod'] + p['b_mod']
    mod_c = jax.nn.silu(c_ctx) @ p['w_mod'] + p['b_mod']
    sh1, sc1, g1, sh2, sc2, g2 = [m[:, None, :] for m in jnp.split(mod, 6, axis=-1)]
    shc1, scc1, gc1, shc2, scc2, gc2 = jnp.split(mod_c, 6, axis=-1)

    h = rmsnorm(x, p['pre_mix_g']) * (1 + sc1) + sh1
    hc = rmsnorm(xc, p['pre_mix_g']) * (1 + scc1) + shc1
    t = token_tensors(h, p, rope)
    tc = token_tensors(hc, p, None)

    zr = jnp.zeros((bsz, RET_HEADS, RET_DK, RET_DV), jnp.float32)
    zs = jnp.zeros((bsz, SSD_HEADS, SSD_STATE, SSD_HEAD_DIM), jnp.float32)
    ret_c, rs_f, rs_b = bidir_scan(tc['rq'], tc['rk'], tc['rk'], tc['rv'], tc['ret_lf'], tc['ret_lb'], zr, zr)
    ssd_c, ss_f, ss_b = bidir_scan(tc['cs'], tc['k_f'], tc['k_b'], tc['xs'], tc['la_f'], tc['la_b'], zs, zs)

    k_all = jnp.concatenate([tc['ak'], t['ak']], axis=1)
    v_all = jnp.concatenate([tc['av'], t['av']], axis=1)
    att = block_attention(t['aq'], k_all, v_all)
    ret, _, _ = bidir_scan(t['rq'], t['rk'], t['rk'], t['rv'], t['ret_lf'], t['ret_lb'], rs_f, rs_b)
    ssd, _, _ = bidir_scan(t['cs'], t['k_f'], t['k_b'], t['xs'], t['la_f'], t['la_b'], ss_f, ss_b)
    m = mixer_output(att, ret, ssd, t, p)
    x = x + g1 * rmsnorm(m, p['post_mix_g'])
    f = swiglu(rmsnorm(x, p['pre_ffn_g']) * (1 + sc2) + sh2, p)
    x = x + g2 * rmsnorm(f, p['post_ffn_g'])

    if not last:
        att_c = block_attention(tc['aq'], tc['ak'], tc['av'])
        mc = mixer_output(att_c, ret_c, ssd_c, tc, p)
        xc = xc + gc1 * rmsnorm(mc, p['post_mix_g'])
        fc = swiglu(rmsnorm(xc, p['pre_ffn_g']) * (1 + scc2) + shc2, p)
        xc = xc + gc2 * rmsnorm(fc, p['post_ffn_g'])
    return x, xc


def setup_inputs(seed: int = 0) -> dict:
    key = jax.random.key(seed)
    ks = jax.random.split(key, 32)
    f32 = jnp.float32
    nrm = lambda k, shape, s: jax.random.normal(k, shape, f32) * s
    L = DEPTH
    lo, hi = math.log(1e-3), math.log(1e-1)
    dt_f = jnp.exp(jax.random.uniform(ks[17], (L, SSD_HEADS), f32) * (hi - lo) + lo)
    dt_b = jnp.exp(jax.random.uniform(ks[18], (L, SSD_HEADS), f32) * (hi - lo) + lo)
    base_decay = -5.0 - jnp.arange(RET_HEADS, dtype=f32)
    return {
        "x": nrm(ks[0], (BATCH, SEQ, D_MODEL), 1.0),
        "c": nrm(ks[1], (BATCH, D_MODEL), 1.0),
        "ctx": nrm(ks[2], (BATCH, CTX_LEN, D_MODEL), 1.0),
        "c_ctx": nrm(ks[3], (D_MODEL,), 1.0),
        "w_mod": nrm(ks[4], (L, D_MODEL, 6 * D_MODEL), 0.5 * D_MODEL ** -0.5),
        "b_mod": nrm(ks[5], (L, 6 * D_MODEL), 0.02),
        "pre_mix_g": 1.0 + nrm(ks[6], (L, D_MODEL), 0.02),
        "post_mix_g": 1.0 + nrm(ks[7], (L, D_MODEL), 0.02),
        "pre_ffn_g": 1.0 + nrm(ks[8], (L, D_MODEL), 0.02),
        "post_ffn_g": 1.0 + nrm(ks[9], (L, D_MODEL), 0.02),
        "w_in": nrm(ks[10], (L, D_MODEL, D_IN), D_MODEL ** -0.5),
        "q_norm_g": 1.0 + nrm(ks[11], (L, HEAD_DIM), 0.02),
        "k_norm_g": 1.0 + nrm(ks[12], (L, HEAD_DIM), 0.02),
        "ret_decay_f": base_decay + nrm(ks[13], (L, RET_HEADS), 0.1),
        "ret_decay_b": base_decay + nrm(ks[14], (L, RET_HEADS), 0.1),
        "conv_w": nrm(ks[15], (L, SSD_CONV, CONV_CH), SSD_CONV ** -0.5),
        "conv_b": nrm(ks[16], (L, CONV_CH), 0.02),
        "dt_bias_f": dt_f + jnp.log(-jnp.expm1(-dt_f)),
        "dt_bias_b": dt_b + jnp.log(-jnp.expm1(-dt_b)),
        "a_log_f": jnp.log(jax.random.uniform(ks[19], (L, SSD_HEADS), f32, 1.0, 16.0)),
        "a_log_b": jnp.log(jax.random.uniform(ks[20], (L, SSD_HEADS), f32, 1.0, 16.0)),
        "d_skip": 1.0 + nrm(ks[21], (L, SSD_HEADS), 0.02),
        "ssd_norm_g": 1.0 + nrm(ks[22], (L, SSD_W), 0.02),
        "w_out": nrm(ks[23], (L, D_MIX, D_MODEL), D_MIX ** -0.5),
        "w_gate": nrm(ks[24], (L, D_MODEL, D_FF), D_MODEL ** -0.5),
        "w_up": nrm(ks[25], (L, D_MODEL, D_FF), D_MODEL ** -0.5),
        "w_down": nrm(ks[26], (L, D_FF, D_MODEL), D_FF ** -0.5),
    }


def reference(x, c, ctx, c_ctx, w_mod, b_mod, pre_mix_g, post_mix_g, pre_ffn_g, post_ffn_g, w_in,
              q_norm_g, k_norm_g, ret_decay_f, ret_decay_b, conv_w, conv_b, dt_bias_f, dt_bias_b,
              a_log_f, a_log_b, d_skip, ssd_norm_g, w_out, w_gate, w_up, w_down):
    n_lat = x.shape[1]
    ROWS = n_lat // GRID_W
    rope = axial_rope(ROWS)
    xc = ctx
    for i in range(DEPTH):
        p = dict(w_mod=w_mod[i], b_mod=b_mod[i], pre_mix_g=pre_mix_g[i], post_mix_g=post_mix_g[i],
                 pre_ffn_g=pre_ffn_g[i], post_ffn_g=post_ffn_g[i], w_in=w_in[i], q_norm_g=q_norm_g[i],
                 k_norm_g=k_norm_g[i], ret_decay_f=ret_decay_f[i], ret_decay_b=ret_decay_b[i],
                 conv_w=conv_w[i], conv_b=conv_b[i], dt_bias_f=dt_bias_f[i], dt_bias_b=dt_bias_b[i],
                 a_log_f=a_log_f[i], a_log_b=a_log_b[i], d_skip=d_skip[i], ssd_norm_g=ssd_norm_g[i],
                 w_out=w_out[i], w_gate=w_gate[i], w_up=w_up[i], w_down=w_down[i])
        x, xc = hybrid_layer(x, xc, c, c_ctx, p, rope, last=(i == DEPTH - 1))
    return x
```

```cpp
#define TAILCUT 49152
#include <hip/hip_runtime.h>
#include <hip/hip_cooperative_groups.h>
#include <cstdio>
#include <cstdint>
namespace cg = cooperative_groups;
__device__ __forceinline__ int otid() { int t = threadIdx.x; asm volatile("" : "+v"(t)); return t; }
namespace pg8 {
#define PG8_LAS __attribute__((address_space(3)))
typedef unsigned short bf16_t;
typedef short bf16x8 __attribute__((ext_vector_type(8)));
typedef float f32x4 __attribute__((ext_vector_type(4)));
typedef unsigned u32x4 __attribute__((ext_vector_type(4)));
constexpr int BM = 256, BK = 64, HALF = 128, HTB = HALF * BK * 2  , STAGE_BYTES = 8 * HTB, NXCD = 8, WGM = 8;

__host__ __device__ __forceinline__ int lds_byte(int r, int c) { const int st = (r >> 4) * 2 + (c >> 5), rr = r & 15, cc = c & 31, ob = rr * 64 + cc * 2; return st * 1024 + (ob ^ (((ob >> 9) & 1) << 5)); }
__host__ __device__ __forceinline__ void stage_rc(int b, int& R, int& C) { const int st = b / 1024, sb = b % 1024, swz = sb ^ (((sb >> 9) & 1) << 5); R = (st >> 1) * 16 + swz / 64; C = (st & 1) * 32 + (swz % 64) / 2; }
__host__ __device__ __forceinline__ int perm32(int rho) { const int n = rho >> 4, i = rho & 15; return 8 * (i >> 2) + 4 * n + (i & 3); }

struct Unit { int pm, pn; };
struct Gemm { const bf16_t* A; const bf16_t* Bt; int M, N, K; };

struct StaticOrder {
    int nM, nN, nwg, G, c;
    __host__ __device__ void init(int M, int N, int G_, int c_) { nM = M / BM; nN = N / BM; nwg = nM * nN; G = G_; c = c_; }
    __host__ __device__ bool next(int i, Unit& u) const {
        const long L = (long)i * G + c; if (L >= nwg) return false;
        int wgid = (int)L; { const int q = nwg / NXCD, r = nwg % NXCD, xcd = wgid % NXCD, off = wgid / NXCD; wgid = (xcd < r ? xcd * (q + 1) : r * (q + 1) + (xcd - r) * q) + off; }
        const int nig = WGM * nN, gid = wgid / nig, fm = gid * WGM, gsz = (nM - fm) < WGM ? (nM - fm) : WGM;
        u.pm = fm + ((wgid % nig) % gsz); u.pn = (wgid % nig) / gsz; return true;
    }
    __device__ __forceinline__ void a_ready(const Unit&) const {}
    __device__ __forceinline__ void done(const Unit&) const {}
};

__device__ __forceinline__ unsigned cvt_pk_bf16(float lo, float hi) { unsigned r; asm volatile("v_cvt_pk_bf16_f32 %0, %1, %2" : "=v"(r) : "v"(lo), "v"(hi)); return r; }
typedef float f32x2 __attribute__((ext_vector_type(2)));
__device__ __forceinline__ float silu_f(float x) { return x * __builtin_amdgcn_rcpf(1.0f + __builtin_amdgcn_exp2f(-1.4426950408889634f * x)); }
struct EpiStore {
    static constexpr bool PERM = true, AFTER_DRAIN = false;
    bf16_t* O; int ldc; float* dt; int dt_pn;
    __device__ __forceinline__ void operator()(const f32x4 (&acc)[2][2][4][2], const Unit& u, int wr, int wc, int fr, int fq) const {
        const int row0 = u.pm * BM + wr * 64 + fr; const int col0 = u.pn * BM + wc * 32 + 8 * fq;
#pragma unroll
        for (int ai = 0; ai < 2; ++ai)
#pragma unroll
            for (int m = 0; m < 4; ++m) { bf16_t* rowp = O + (size_t)(row0 + ai * HALF + m * 16) * ldc + col0;
#pragma unroll
                for (int bj = 0; bj < 2; ++bj) { const f32x4 v0 = acc[ai][bj][m][0], v1 = acc[ai][bj][m][1];
                    u32x4 w; w.x = cvt_pk_bf16(v0[0], v0[1]); w.y = cvt_pk_bf16(v0[2], v0[3]); w.z = cvt_pk_bf16(v1[0], v1[1]); w.w = cvt_pk_bf16(v1[2], v1[3]);
                    *(u32x4*)(rowp + bj * HALF) = w; } }
        if (dt != nullptr && u.pn == dt_pn && wc == 0 && fq < 3) {
#pragma unroll
            for (int ai = 0; ai < 2; ++ai)
#pragma unroll
                for (int m = 0; m < 4; ++m) { float* d = dt + (size_t)(row0 + ai * HALF + m * 16) * 24 + 8 * fq;
                    *(f32x4*)d = acc[ai][0][m][0]; *(f32x4*)(d + 4) = acc[ai][0][m][1]; }
        }
    }
};
struct EpiSwiglu {
    static constexpr bool PERM = true, AFTER_DRAIN = false;
    bf16_t* O; int ldc;
    __device__ __forceinline__ void operator()(const f32x4 (&acc)[2][2][4][2], const Unit& u, int wr, int wc, int fr, int fq) const {
        const int row0 = u.pm * BM + wr * 64 + fr; const int col0 = u.pn * HALF + wc * 32 + 8 * fq;
#pragma unroll
        for (int ai = 0; ai < 2; ++ai)
#pragma unroll
            for (int m = 0; m < 4; ++m) { bf16_t* rowp = O + (size_t)(row0 + ai * HALF + m * 16) * ldc + col0;
                const f32x4 g0 = acc[ai][0][m][0], g1 = acc[ai][0][m][1], u0 = acc[ai][1][m][0], u1 = acc[ai][1][m][1];
                u32x4 w; w.x = cvt_pk_bf16(silu_f(g0[0]) * u0[0], silu_f(g0[1]) * u0[1]); w.y = cvt_pk_bf16(silu_f(g0[2]) * u0[2], silu_f(g0[3]) * u0[3]);
                w.z = cvt_pk_bf16(silu_f(g1[0]) * u1[0], silu_f(g1[1]) * u1[1]); w.w = cvt_pk_bf16(silu_f(g1[2]) * u1[2], silu_f(g1[3]) * u1[3]);
                *(u32x4*)rowp = w; }
    }
};
struct InprojOrder {
    StaticOrder base; int G, c, skip;
    __device__ void init(int G_, int c_, int skip_) { base.init(16384, 5632, G_, c_); G = G_; c = c_; skip = skip_; }
    __device__ bool next(int i, Unit& u) const {
        if (base.next(i, u)) return true;
        const int j = i * G + c - base.nwg, nextra = skip ? 96 : 176;
        if (j >= nextra) return false;
        const int jj = j >> 3; u.pm = 64 + (j & 7); u.pn = skip ? (jj < 2 ? 3 + jj : (jj < 6 ? 5 + jj : 10 + jj)) : jj; return true;
    }
    __device__ __forceinline__ void a_ready(const Unit&) const {}
    __device__ __forceinline__ void done(const Unit&) const {}
};
template <class Epi, class Sched, bool ALIGN_EPI = false, bool SP2 = false>
__device__ __forceinline__ void gemm_phase(PG8_LAS unsigned char* lds, const Gemm g, const Sched& S, const Epi& E) {
    const int tid = otid(), wid = __builtin_amdgcn_readfirstlane(tid >> 6), lane = tid & 63, wr = wid >> 2, wc = wid & 3, fr = lane & 15, fq = lane >> 4;
    const int K = g.K, nt = K / BK;
    unsigned voffA[2], voffB[2];
#pragma unroll
    for (int i = 0; i < 2; ++i) { int R, C; stage_rc(tid * 16 + i * 8192, R, C); const int Rb = Epi::PERM ? ((R & ~31) + perm32(R & 31)) : R;
        voffA[i] = (unsigned)(R * K + C) * 2u; voffB[i] = (unsigned)(Rb * K + C) * 2u; }
    const size_t kstep = (size_t)(BK * 2);
    const size_t hstep = (size_t)HALF * K * 2;
    const size_t tstep = 2 * hstep;
    const unsigned ldsw = (unsigned)wid * 1024u;
    const int aoff = lds_byte(wr * 64 + fr, fq * 8), boff = lds_byte(wc * 32 + fr, fq * 8);
#define PG8_SA(b, h) (((b) * 2 + (h)) * HTB)
#define PG8_SB(b, h) ((4 + (b) * 2 + (h)) * HTB)
#define PG8_STAGE(bufoff, gbase, voff) do { _Pragma("unroll") for (int _i = 0; _i < 2; ++_i) \
        __builtin_amdgcn_global_load_lds((const unsigned*)((const char*)(gbase) + (voff)[_i]), (PG8_LAS unsigned*)(lds + (bufoff) + ldsw + _i * 8192), 16, 0, 0); } while (0)
#define PG8_LDA(dst, b, h) do { _Pragma("unroll") for (int m = 0; m < 4; ++m) _Pragma("unroll") for (int k = 0; k < 2; ++k) dst[m][k] = *(const PG8_LAS bf16x8*)(lds + PG8_SA(b, h) + aoff + m * 2048 + k * 1024); } while (0)
#define PG8_LDB(dst, b, h) do { _Pragma("unroll") for (int n = 0; n < 2; ++n) _Pragma("unroll") for (int k = 0; k < 2; ++k) dst[n][k] = *(const PG8_LAS bf16x8*)(lds + PG8_SB(b, h) + boff + n * 2048 + k * 1024); } while (0)
#define PG8_MMA(ai, bj, At, Bt) do { __builtin_amdgcn_s_setprio(1); _Pragma("unroll") for (int m = 0; m < 4; ++m) _Pragma("unroll") for (int n = 0; n < 2; ++n) _Pragma("unroll") for (int k = 0; k < 2; ++k) \
        acc[ai][bj][m][n] = __builtin_amdgcn_mfma_f32_16x16x32_bf16(Bt[n][k], At[m][k], acc[ai][bj][m][n], 0, 0, 0); __builtin_amdgcn_s_setprio(0); } while (0)
#define PG8_WAIT_V(n) asm volatile("s_waitcnt vmcnt(" #n ")" ::: "memory")
#define PG8_WAIT_L(n) asm volatile("s_waitcnt lgkmcnt(" #n ")" ::: "memory")
#define PG8_BAR __builtin_amdgcn_s_barrier()
#define PG8_SCHED __builtin_amdgcn_sched_barrier(0)
    Unit cur, nxt; int ui = 0;
    if (!S.next(0, cur)) return;
    f32x4 acc[2][2][4][2];
#pragma unroll
    for (int a = 0; a < 2; ++a)
#pragma unroll
        for (int b = 0; b < 2; ++b)
#pragma unroll
            for (int m = 0; m < 4; ++m)
#pragma unroll
                for (int n = 0; n < 2; ++n) acc[a][b][m][n] = (f32x4){0.f, 0.f, 0.f, 0.f};
    bf16x8 At[4][2], B0[2][2], B1[2][2];
    const char* cA = (const char*)g.A + (size_t)cur.pm * tstep; const char* cB = (const char*)g.Bt + (size_t)cur.pn * tstep;
    S.a_ready(cur);
    if constexpr (SP2) {
        PG8_STAGE(PG8_SB(0, 0), cB, voffB); PG8_STAGE(PG8_SB(0, 1), cB + hstep, voffB); PG8_STAGE(PG8_SA(0, 0), cA, voffA); PG8_STAGE(PG8_SA(0, 1), cA + hstep, voffA);
        if (wr == 1) PG8_BAR;
        PG8_WAIT_V(2); PG8_BAR;
        PG8_STAGE(PG8_SB(1, 0), cB + kstep, voffB); PG8_STAGE(PG8_SA(1, 0), cA + kstep, voffA); PG8_STAGE(PG8_SB(1, 1), cB + hstep + kstep, voffB);
        PG8_WAIT_V(6); PG8_BAR;
    } else {
        PG8_STAGE(PG8_SB(0, 0), cB, voffB); PG8_STAGE(PG8_SA(0, 0), cA, voffA); PG8_STAGE(PG8_SB(0, 1), cB + hstep, voffB); PG8_STAGE(PG8_SA(0, 1), cA + hstep, voffA);
        if (wr == 1) PG8_BAR;
        PG8_WAIT_V(4); PG8_BAR;
        PG8_STAGE(PG8_SB(1, 0), cB + kstep, voffB); PG8_STAGE(PG8_SA(1, 0), cA + kstep, voffA); PG8_STAGE(PG8_SB(1, 1), cB + hstep + kstep, voffB);
        PG8_WAIT_V(6); PG8_BAR;
    }
    for (;;) {
        const bool has_next = S.next(ui + 1, nxt);
        const char* nA = has_next ? (const char*)g.A + (size_t)nxt.pm * tstep : cA; const char* nB = has_next ? (const char*)g.Bt + (size_t)nxt.pn * tstep : cB;
        for (int t = 0; t < nt; t += 2) {
            const bool last = (t == nt - 2);
            const char* a1 = cA + (size_t)(t + 1) * kstep;
            const char* a2 = last ? nA : cA + (size_t)(t + 2) * kstep; const char* b2 = last ? nB : cB + (size_t)(t + 2) * kstep;
            const char* a3 = a2 + kstep; const char* b3 = b2 + kstep;
            if (last && has_next) S.a_ready(nxt);
            if constexpr (SP2) {
            PG8_LDB(B0, 0, 0); PG8_LDB(B1, 0, 1); PG8_SCHED; PG8_LDA(At, 0, 0); PG8_STAGE(PG8_SA(1, 1), a1 + hstep, voffA);
            PG8_WAIT_V(8); PG8_WAIT_L(0); PG8_BAR; PG8_MMA(0, 0, At, B0); PG8_MMA(0, 1, At, B1); PG8_BAR; PG8_SCHED;
            PG8_LDA(At, 0, 1); PG8_STAGE(PG8_SB(0, 0), b2, voffB); PG8_STAGE(PG8_SB(0, 1), b2 + hstep, voffB); PG8_STAGE(PG8_SA(0, 0), a2, voffA);
            PG8_WAIT_V(8); PG8_WAIT_L(0); PG8_BAR; PG8_MMA(1, 0, At, B0); PG8_MMA(1, 1, At, B1); PG8_BAR; PG8_SCHED;
            PG8_LDB(B0, 1, 0); PG8_LDB(B1, 1, 1); PG8_SCHED; PG8_LDA(At, 1, 0); PG8_STAGE(PG8_SA(0, 1), a2 + hstep, voffA);
            PG8_WAIT_V(8); PG8_WAIT_L(0); PG8_BAR; PG8_MMA(0, 0, At, B0); PG8_MMA(0, 1, At, B1); PG8_BAR; PG8_SCHED;
            PG8_LDA(At, 1, 1); PG8_STAGE(PG8_SB(1, 0), b3, voffB); PG8_STAGE(PG8_SB(1, 1), b3 + hstep, voffB); PG8_STAGE(PG8_SA(1, 0), a3, voffA);
            PG8_WAIT_V(8); PG8_WAIT_L(0); PG8_BAR; PG8_MMA(1, 0, At, B0); PG8_MMA(1, 1, At, B1); PG8_BAR; PG8_SCHED;
            } else {
            PG8_LDB(B0, 0, 0); PG8_SCHED; PG8_LDA(At, 0, 0); PG8_STAGE(PG8_SA(1, 1), a1 + hstep, voffA);
            PG8_WAIT_L(8); PG8_BAR; PG8_WAIT_L(0); PG8_MMA(0, 0, At, B0); PG8_BAR; PG8_SCHED;
            PG8_LDB(B1, 0, 1); PG8_STAGE(PG8_SB(0, 0), b2, voffB);
            PG8_BAR; PG8_WAIT_L(0); PG8_MMA(0, 1, At, B1); PG8_BAR;
            PG8_LDA(At, 0, 1); PG8_STAGE(PG8_SA(0, 0), a2, voffA);
            PG8_BAR; PG8_WAIT_L(0); PG8_MMA(1, 0, At, B0); PG8_BAR; PG8_SCHED;
            PG8_STAGE(PG8_SB(0, 1), b2 + hstep, voffB);
            PG8_WAIT_V(6); PG8_BAR; PG8_MMA(1, 1, At, B1); PG8_BAR;
            PG8_LDB(B0, 1, 0); PG8_SCHED; PG8_LDA(At, 1, 0); PG8_STAGE(PG8_SA(0, 1), a2 + hstep, voffA);
            PG8_WAIT_L(8); PG8_BAR; PG8_WAIT_L(0); PG8_MMA(0, 0, At, B0); PG8_BAR; PG8_SCHED;
            PG8_LDB(B1, 1, 1); PG8_STAGE(PG8_SB(1, 0), b3, voffB);
            PG8_BAR; PG8_WAIT_L(0); PG8_MMA(0, 1, At, B1); PG8_BAR;
            PG8_LDA(At, 1, 1); PG8_STAGE(PG8_SA(1, 0), a3, voffA);
            PG8_BAR; PG8_WAIT_L(0); PG8_MMA(1, 0, At, B0); PG8_BAR; PG8_SCHED;
            PG8_STAGE(PG8_SB(1, 1), b3 + hstep, voffB);
            PG8_WAIT_V(6); PG8_BAR; PG8_MMA(1, 1, At, B1); PG8_BAR;
            }
        }
        if constexpr (ALIGN_EPI) { if (wr == 0) PG8_BAR; }
        if constexpr (!Epi::AFTER_DRAIN) { E(acc, cur, wr, wc, fr, fq); S.done(cur); }
        if (!has_next) break;
#pragma unroll
        for (int a = 0; a < 2; ++a)
#pragma unroll
            for (int b = 0; b < 2; ++b)
#pragma unroll
                for (int m = 0; m < 4; ++m)
#pragma unroll
                    for (int n = 0; n < 2; ++n) acc[a][b][m][n] = (f32x4){0.f, 0.f, 0.f, 0.f};
        cur = nxt; cA = nA; cB = nB; ++ui;
        if constexpr (ALIGN_EPI) { if (wr == 1) PG8_BAR; }
    }
    PG8_WAIT_V(0);
    if constexpr (!ALIGN_EPI) { if (wr == 0) PG8_BAR; }
    PG8_BAR;
    if constexpr (Epi::AFTER_DRAIN) { E.fused(acc, cur, wr, wc, fr, fq, lds, wid, lane); S.done(cur); }
#undef PG8_SA
#undef PG8_SB
#undef PG8_STAGE
#undef PG8_LDA
#undef PG8_LDB
#undef PG8_MMA
#undef PG8_WAIT_V
#undef PG8_WAIT_L
#undef PG8_BAR
#undef PG8_SCHED
}
}
namespace mx {
typedef unsigned short bf16;
using bf16x8 = __attribute__((ext_vector_type(8))) short;
using s16x4  = __attribute__((ext_vector_type(4))) short;
using f32x16 = __attribute__((ext_vector_type(16))) float;
using f32x4  = __attribute__((ext_vector_type(4))) float;
using u32x4  = __attribute__((ext_vector_type(4))) unsigned;
constexpr int D = 128, NW = 8, QBLK = 32, KVBLK = 64;
constexpr float SCALE = 0.088388347648318440f;
constexpr float THR = 8.f;
constexpr int SHM_V = KVBLK * D * 2, SHM_K = KVBLK * D * 2;
constexpr int NSTAGE = 3, STAGE_B = SHM_V + SHM_K;
constexpr int OFF_WS = NSTAGE * STAGE_B;
constexpr int OFF_MK = OFF_WS + NW * 1024;
constexpr int NKEYMAX = 2304;
#define KSWZ(row, colB) ((row) * 256 + ((colB) ^ (((row) & 7) << 4)))
#define SBAR() __builtin_amdgcn_sched_barrier(0)
__device__ __forceinline__ int crow(int r, int hi) { return (r & 3) + 8 * (r >> 2) + 4 * hi; }
__device__ __forceinline__ unsigned cvtpk(float lo, float hi) { unsigned r; asm volatile("v_cvt_pk_bf16_f32 %0, %1, %2" : "=v"(r) : "v"(lo), "v"(hi)); return r; }
__device__ __forceinline__ bf16x8 ld8(const bf16* p) { return *reinterpret_cast<const bf16x8*>(p); }
__device__ __forceinline__ float bf2f(bf16 v) { return __uint_as_float((unsigned)v << 16); }
__device__ __forceinline__ bf16 f2bf(float f) { return (bf16)(cvtpk(f, f) & 0xffffu); }

__device__ __forceinline__ void partialSM(f32x16& p0, f32x16& p1, float& m_reg, float& mn, float& alpha) {
  constexpr float C = SCALE * 1.4426950408889634f;
  float pmax = p0[0];
#pragma unroll
  for (int r = 1; r < 16; ++r) pmax = fmaxf(pmax, p0[r]);
#pragma unroll
  for (int r = 0; r < 16; ++r) pmax = fmaxf(pmax, p1[r]);
  { auto rr = __builtin_amdgcn_permlane32_swap(__float_as_uint(pmax), __float_as_uint(pmax), false, false);
    pmax = fmaxf(__uint_as_float(rr[0]), __uint_as_float(rr[1])); }
  if (__builtin_expect(__all(pmax - m_reg <= THR / SCALE), 1)) { mn = m_reg; alpha = 1.f; }
  else { mn = fmaxf(m_reg, pmax); alpha = __builtin_amdgcn_exp2f((m_reg - mn) * C); m_reg = mn; }
  float mnC = -mn * C;
#pragma unroll
  for (int r = 0; r < 16; ++r) p0[r] = fmaf(p0[r], C, mnC);
#pragma unroll
  for (int r = 0; r < 16; ++r) p1[r] = fmaf(p1[r], C, mnC);
#pragma unroll
  for (int r = 0; r < 16; ++r) p0[r] = __builtin_amdgcn_exp2f(p0[r]);
}
#define PK4(P, BASE, OUT) do { unsigned a0 = cvtpk(P[BASE + 0], P[BASE + 1]), a1 = cvtpk(P[BASE + 2], P[BASE + 3]);   \
    unsigned b0 = cvtpk(P[BASE + 4], P[BASE + 5]), b1 = cvtpk(P[BASE + 6], P[BASE + 7]);                              \
    auto r0 = __builtin_amdgcn_permlane32_swap(a0, b0, false, false); auto r1 = __builtin_amdgcn_permlane32_swap(a1, b1, false, false); \
    u32x4 w = {r0[0], r1[0], r0[1], r1[1]}; OUT = *reinterpret_cast<bf16x8*>(&w); } while (0)
__device__ __forceinline__ void finishSM(f32x16& p0, f32x16& p1, float alpha, float& l_reg, bf16x8& pa0, bf16x8& pa1, bf16x8& pa2, bf16x8& pa3) {
#pragma unroll
  for (int r = 0; r < 16; ++r) p1[r] = __builtin_amdgcn_exp2f(p1[r]);
  float ps = 0;
#pragma unroll
  for (int r = 0; r < 16; ++r) ps += p0[r];
#pragma unroll
  for (int r = 0; r < 16; ++r) ps += p1[r];
  { auto rr = __builtin_amdgcn_permlane32_swap(__float_as_uint(ps), __float_as_uint(ps), false, false);
    ps = __uint_as_float(rr[0]) + __uint_as_float(rr[1]); }
  l_reg = l_reg * alpha + ps;
  PK4(p0, 0, pa0); PK4(p0, 8, pa1); PK4(p1, 0, pa2); PK4(p1, 8, pa3);
}
__device__ __forceinline__ void qkt(f32x16& p0, f32x16& p1, const bf16* Ks, const bf16x8* qr, int r32, int hi) {
  p0 = f32x16{}; p1 = f32x16{};
#define LDK(d0_, h_) (*reinterpret_cast<const bf16x8*>((const char*)Ks + KSWZ((h_) * 32 + r32, ((d0_) * 16 + hi * 8) * 2)))
  bf16x8 a0 = LDK(0, 0), a1 = LDK(0, 1), b0 = LDK(1, 0), b1 = LDK(1, 1);
#pragma unroll
  for (int d0 = 0; d0 < 8; d0 += 2) {
    bf16x8 c0, c1, e0, e1;
    if (d0 + 2 < 8) { c0 = LDK(d0 + 2, 0); c1 = LDK(d0 + 2, 1); } SBAR();
    p0 = __builtin_amdgcn_mfma_f32_32x32x16_bf16(a0, qr[d0], p0, 0, 0, 0);
    p1 = __builtin_amdgcn_mfma_f32_32x32x16_bf16(a1, qr[d0], p1, 0, 0, 0); SBAR();
    if (d0 + 3 < 8) { e0 = LDK(d0 + 3, 0); e1 = LDK(d0 + 3, 1); } SBAR();
    p0 = __builtin_amdgcn_mfma_f32_32x32x16_bf16(b0, qr[d0 + 1], p0, 0, 0, 0);
    p1 = __builtin_amdgcn_mfma_f32_32x32x16_bf16(b1, qr[d0 + 1], p1, 0, 0, 0); SBAR();
    if (d0 + 2 < 8) { a0 = c0; a1 = c1; } if (d0 + 3 < 8) { b0 = e0; b1 = e1; }
  }
#undef LDK
}
__device__ __forceinline__ void qkt_plain(f32x16& p0, f32x16& p1, const bf16* Ks, const bf16x8* qr, int r32, int hi) {
  p0 = f32x16{}; p1 = f32x16{};
#pragma unroll
  for (int d0 = 0; d0 < 8; ++d0) { int cb = (d0 * 16 + hi * 8) * 2;
    bf16x8 b0 = *reinterpret_cast<const bf16x8*>((const char*)Ks + KSWZ(r32, cb));
    bf16x8 b1 = *reinterpret_cast<const bf16x8*>((const char*)Ks + KSWZ(32 + r32, cb));
    p0 = __builtin_amdgcn_mfma_f32_32x32x16_bf16(b0, qr[d0], p0, 0, 0, 0);
    p1 = __builtin_amdgcn_mfma_f32_32x32x16_bf16(b1, qr[d0], p1, 0, 0, 0); }
}
__device__ __forceinline__ int v_st(int k, int c) { const int kk = (k & ~0xC) | ((k & 4) << 1) | ((k & 8) >> 1); return ((kk >> 3) * 4 + (c >> 5)) * 512 + ((kk & 7) * 32 + (c & 31)) * 2; }
__device__ __forceinline__ int v_rd_base(int lane) { return ((lane & 3) << 3) | (((lane >> 2) & 3) << 6) | (((lane >> 4) & 1) << 5) | (((lane >> 5) & 1) << 8); }
constexpr int v_rd_off(int d0, int ks, int half) { return d0 * 512 + ks * 4096 + half * 2048; }
template <int OFF> __device__ __forceinline__ s16x4 tr_read(int vb) {
  s16x4 r; asm volatile("ds_read_b64_tr_b16 %0, %1 offset:%2" : "=&v"(r) : "v"(vb), "i"(OFF) : "memory"); return r;
}
template <int D0> __device__ __forceinline__ void pv_one(f32x16& od, int vb, bf16x8 pa0, bf16x8 pa1, bf16x8 pa2, bf16x8 pa3) {
  const s16x4 l0 = tr_read<v_rd_off(D0, 0, 0)>(vb), h0 = tr_read<v_rd_off(D0, 0, 1)>(vb), l1 = tr_read<v_rd_off(D0, 1, 0)>(vb), h1 = tr_read<v_rd_off(D0, 1, 1)>(vb);
  const s16x4 l2 = tr_read<v_rd_off(D0, 2, 0)>(vb), h2 = tr_read<v_rd_off(D0, 2, 1)>(vb), l3 = tr_read<v_rd_off(D0, 3, 0)>(vb), h3 = tr_read<v_rd_off(D0, 3, 1)>(vb);
  asm volatile("s_waitcnt lgkmcnt(0)" ::: "memory"); SBAR();
#define PK(L, H) (bf16x8){L[0], L[1], L[2], L[3], H[0], H[1], H[2], H[3]}
  od = __builtin_amdgcn_mfma_f32_32x32x16_bf16(pa0, PK(l0, h0), od, 0, 0, 0);
  od = __builtin_amdgcn_mfma_f32_32x32x16_bf16(pa1, PK(l1, h1), od, 0, 0, 0);
  od = __builtin_amdgcn_mfma_f32_32x32x16_bf16(pa2, PK(l2, h2), od, 0, 0, 0);
  od = __builtin_amdgcn_mfma_f32_32x32x16_bf16(pa3, PK(l3, h3), od, 0, 0, 0);
#undef PK
}
#ifdef PV_PIPE
#define PV_RD(D0, L0, H0, L1, H1, L2, H2, L3, H3) do { L0 = tr_read<v_rd_off(D0, 0, 0)>(vb); H0 = tr_read<v_rd_off(D0, 0, 1)>(vb); L1 = tr_read<v_rd_off(D0, 1, 0)>(vb); H1 = tr_read<v_rd_off(D0, 1, 1)>(vb); \
    L2 = tr_read<v_rd_off(D0, 2, 0)>(vb); H2 = tr_read<v_rd_off(D0, 2, 1)>(vb); L3 = tr_read<v_rd_off(D0, 3, 0)>(vb); H3 = tr_read<v_rd_off(D0, 3, 1)>(vb); } while (0)
#define PV_MM(OD, L0, H0, L1, H1, L2, H2, L3, H3) do { \
    OD = __builtin_amdgcn_mfma_f32_32x32x16_bf16(pa0, (bf16x8){L0[0], L0[1], L0[2], L0[3], H0[0], H0[1], H0[2], H0[3]}, OD, 0, 0, 0); \
    OD = __builtin_amdgcn_mfma_f32_32x32x16_bf16(pa1, (bf16x8){L1[0], L1[1], L1[2], L1[3], H1[0], H1[1], H1[2], H1[3]}, OD, 0, 0, 0); \
    OD = __builtin_amdgcn_mfma_f32_32x32x16_bf16(pa2, (bf16x8){L2[0], L2[1], L2[2], L2[3], H2[0], H2[1], H2[2], H2[3]}, OD, 0, 0, 0); \
    OD = __builtin_amdgcn_mfma_f32_32x32x16_bf16(pa3, (bf16x8){L3[0], L3[1], L3[2], L3[3], H3[0], H3[1], H3[2], H3[3]}, OD, 0, 0, 0); } while (0)
__device__ __forceinline__ void pv_d0(f32x16* o, int vb, bf16x8 pa0, bf16x8 pa1, bf16x8 pa2, bf16x8 pa3) {
  s16x4 a0, a1, a2, a3, a4, a5, a6, a7, b0, b1, b2, b3, b4, b5, b6, b7;
  PV_RD(0, a0, a1, a2, a3, a4, a5, a6, a7);
  PV_RD(1, b0, b1, b2, b3, b4, b5, b6, b7);
  asm volatile("s_waitcnt lgkmcnt(8)" ::: "memory"); SBAR();
  PV_MM(o[0], a0, a1, a2, a3, a4, a5, a6, a7); SBAR();
  PV_RD(2, a0, a1, a2, a3, a4, a5, a6, a7);
  asm volatile("s_waitcnt lgkmcnt(8)" ::: "memory"); SBAR();
  PV_MM(o[1], b0, b1, b2, b3, b4, b5, b6, b7); SBAR();
  PV_RD(3, b0, b1, b2, b3, b4, b5, b6, b7);
  asm volatile("s_waitcnt lgkmcnt(8)" ::: "memory"); SBAR();
  PV_MM(o[2], a0, a1, a2, a3, a4, a5, a6, a7); SBAR();
  asm volatile("s_waitcnt lgkmcnt(0)" ::: "memory"); SBAR();
  PV_MM(o[3], b0, b1, b2, b3, b4, b5, b6, b7);
}
#undef PV_RD
#undef PV_MM
#else
__device__ __forceinline__ void pv_d0(f32x16* o, int vb, bf16x8 pa0, bf16x8 pa1, bf16x8 pa2, bf16x8 pa3) {
  pv_one<0>(o[0], vb, pa0, pa1, pa2, pa3); pv_one<1>(o[1], vb, pa0, pa1, pa2, pa3); pv_one<2>(o[2], vb, pa0, pa1, pa2, pa3); pv_one<3>(o[3], vb, pa0, pa1, pa2, pa3);
}
#endif
#define MXLAS __attribute__((address_space(3)))
__device__ __forceinline__ void dma_map(int wid, int lane, int ld, int (&koff)[2], int (&voff)[2]) {
#pragma unroll
  for (int i = 0; i < 2; ++i) { const int b = (2 * wid + i) * 1024 + lane * 16;
    { const int row = b >> 8, colB = (b & 255) ^ ((row & 7) << 4); koff[i] = row * ld + (colB >> 1); }
    { const int sub = b >> 9, e = (b & 511) >> 1, kk = (sub >> 2) * 8 + (e >> 5), c = (sub & 3) * 32 + (e & 31);
      const int k = (kk & ~0xC) | ((kk & 4) << 1) | ((kk & 8) >> 1); voff[i] = k * ld + c; } }
}
#define DMA_ISSUE(T_, st_) do { const long rb_ = tile_row((T_), ctx_row0, lat_row0) * (long)ld; const bf16* kb_ = Kh + rb_; const bf16* vp_ = Vh + rb_; \
    MXLAS unsigned char* sb_ = (MXLAS unsigned char*)lds + (st_) * STAGE_B + wid * 2048; \
    _Pragma("unroll") for (int i_ = 0; i_ < 2; ++i_) { \
      __builtin_amdgcn_global_load_lds((const unsigned*)(vp_ + voff[i_]), (MXLAS unsigned*)(sb_ + i_ * 1024), 16, 0, 0); \
      __builtin_amdgcn_global_load_lds((const unsigned*)(kb_ + koff[i_]), (MXLAS unsigned*)(sb_ + SHM_V + i_ * 1024), 16, 0, 0); } } while (0)
#define RING_SYNC(nwait) do { asm volatile("s_waitcnt vmcnt(" #nwait ") lgkmcnt(0)" ::: "memory"); __builtin_amdgcn_s_barrier(); asm volatile("" ::: "memory"); SBAR(); } while (0)
__device__ __forceinline__ long tile_row(int j, int ctx_row0, int lat_row0) { return j < 4 ? (long)ctx_row0 + 64 * j : (long)lat_row0 + 64 * (j - 4); }

template <bool UF, bool UB, bool MK>
__device__ __forceinline__ void mask_pack(const f32x16& p0, const f32x16& p1, const float* mf, const float* mb, float qf, float qb, int dq,
                                          bf16x8& pa0, bf16x8& pa1, bf16x8& pa2, bf16x8& pa3) {
  float t[8];
#pragma unroll
  for (int half = 0; half < 2; ++half) {
#pragma unroll
    for (int gg = 0; gg < 2; ++gg) {
#pragma unroll
      for (int g2 = 0; g2 < 2; ++g2) { const int g = gg * 2 + g2;
        f32x4 kf4 = {0.f, 0.f, 0.f, 0.f}, kb4 = {0.f, 0.f, 0.f, 0.f};
        if (UF) kf4 = *(const f32x4*)(mf + half * 32 + 8 * g);
        if (UB) kb4 = *(const f32x4*)(mb + half * 32 + 8 * g);
#pragma unroll
        for (int i = 0; i < 4; ++i) { const int ko = half * 32 + 8 * g + i; float w = 0.f;
          if (UF) { float e = __builtin_amdgcn_exp2f(qf - kf4[i]); if (MK) e = (ko <= dq) ? e : 0.f; w += e; }
          if (UB) { float e = __builtin_amdgcn_exp2f(qb - kb4[i]); if (MK) e = (ko >= dq) ? e : 0.f; w += e; }
          const float s = half == 0 ? p0[4 * g + i] : p1[4 * g + i];
          t[g2 * 4 + i] = s * w; }
      }
      bf16x8 out; PK4(t, 0, out); SBAR();
      if (half == 0) { if (gg == 0) pa0 = out; else pa1 = out; } else { if (gg == 0) pa2 = out; else pa3 = out; }
    }
  }
}

template <bool UF, bool UB>
__device__ __forceinline__ void mask_pack_fact(const f32x16& p0, const f32x16& p1, const float* bf, const float* bb, float af, float ab,
                                               bf16x8& pa0, bf16x8& pa1, bf16x8& pa2, bf16x8& pa3) {
  float t[8];
#pragma unroll
  for (int half = 0; half < 2; ++half) {
#pragma unroll
    for (int gg = 0; gg < 2; ++gg) {
#pragma unroll
      for (int g2 = 0; g2 < 2; ++g2) { const int g = gg * 2 + g2;
        f32x4 f4 = {0.f, 0.f, 0.f, 0.f}, b4 = {0.f, 0.f, 0.f, 0.f};
        if (UF) f4 = *(const f32x4*)(bf + half * 32 + 8 * g);
        if (UB) b4 = *(const f32x4*)(bb + half * 32 + 8 * g);
#pragma unroll
        for (int i = 0; i < 4; ++i) { const float s = half == 0 ? p0[4 * g + i] : p1[4 * g + i];
          float w;
          if (UF && UB) w = af * f4[i] + ab * b4[i]; else if (UF) w = af * f4[i]; else w = ab * b4[i];
          t[g2 * 4 + i] = s * w; }
      }
      bf16x8 out; PK4(t, 0, out); SBAR();
      if (half == 0) { if (gg == 0) pa0 = out; else pa1 = out; } else { if (gg == 0) pa2 = out; else pa3 = out; }
    }
  }
}

template <int NH>
__device__ __forceinline__ void lin_body(const bf16* __restrict__ Qb, const bf16* __restrict__ Kh, const bf16* __restrict__ Vh, int ld, int ctx_row0, int lat_row0, int NT,
                                         const float* __restrict__ msk, int qn0, int tq0, bool latq, f32x16 (&o)[4], char* lds) {
  const int tid = otid(), wid = __builtin_amdgcn_readfirstlane(tid >> 6), lane = tid & 63, r32 = lane & 31, hi = lane >> 5;
  float* mk = (float*)(lds + OFF_MK);
  bf16x8 qr[8];
#pragma unroll
  for (int d = 0; d < 4; ++d) o[d] = f32x16{};
  const bf16* Qw = Qb + (long)(wid * QBLK + r32) * ld + hi * 8;
#pragma unroll
  for (int d0 = 0; d0 < 8; ++d0) qr[d0] = ld8(Qw + d0 * 16);
  { float tmpm[NH * 9];
#pragma unroll
    for (int it = 0; it < NH * 9; ++it) { const int i = it * 512 + tid, a = i / NKEYMAX, n = i - a * NKEYMAX; tmpm[it] = msk[(size_t)((a >> 1) * 4 + 1 + 2 * (a & 1)) * NKEYMAX + n]; }
#pragma unroll
    for (int it = 0; it < NH * 9; ++it) { const int i = it * 512 + tid; mk[i] = tmpm[it]; } }
  float qf[NH], qb[NH];
#pragma unroll
  for (int hh = 0; hh < NH; ++hh) { const int nq = qn0 + wid * QBLK + r32; qf[hh] = msk[(size_t)(hh * 4 + 0) * NKEYMAX + nq]; qb[hh] = msk[(size_t)(hh * 4 + 2) * NKEYMAX + nq]; }
  const int tw0 = tq0 + wid * QBLK;
  float reff[NH], refb[NH], af[NH], ab[NH];
#pragma unroll
  for (int hh = 0; hh < NH; ++hh) { reff[hh] = __shfl(qf[hh], 0); refb[hh] = __shfl(qb[hh], 31);
    af[hh] = __builtin_amdgcn_exp2f(qf[hh] - reff[hh]); ab[hh] = __builtin_amdgcn_exp2f(qb[hh] - refb[hh]); }
  float* wsc = (float*)(lds + OFF_WS) + wid * 256;
  int koff[2], voff[2]; dma_map(wid, lane, ld, koff, voff);
  const int vb0 = (int)(uintptr_t)lds + v_rd_base(lane);
  DMA_ISSUE(0, 0); DMA_ISSUE(1, 1);
  RING_SYNC(4);
  int st = 0;
  for (int T = 0; T < NT; ++T) {
    if (T + 2 < NT) { const int s2 = st == 0 ? 2 : st - 1; DMA_ISSUE(T + 2, s2); }
    f32x16 p0, p1;
    qkt_plain(p0, p1, (const bf16*)(lds + st * STAGE_B + SHM_V), qr, r32, hi);
    int mode, s0 = 0;
    if (latq && T < 4) mode = 0;
    else { s0 = 64 * (T - (latq ? 4 : 0)); mode = (s0 + 63 < tw0) ? 1 : ((s0 > tw0 + 31) ? 2 : 3); }
    const int dq = tw0 + r32 - s0 - 4 * hi;
    const int vb = vb0 + st * STAGE_B;
#pragma unroll
    for (int hh = 0; hh < NH; ++hh) {
      const float* mf = mk + (hh * 2 + 0) * NKEYMAX + T * 64 + 4 * hi; const float* mb = mk + (hh * 2 + 1) * NKEYMAX + T * 64 + 4 * hi;
      bf16x8 pa0, pa1, pa2, pa3;
      int dqh = dq; asm volatile("" : "+v"(dqh));
#ifdef MODE_GENERAL_ONLY
      mask_pack<true, true, true>(p0, p1, mf, mb, qf[hh], qb[hh], (mode == 0 ? (hh, 1000) : (mode == 1 ? 1000 : (mode == 2 ? -1000 : dq))), pa0, pa1, pa2, pa3);
#else
      if (mode != 3) {
        if (mode != 2) wsc[(hh * 2 + 0) * 64 + lane] = __builtin_amdgcn_exp2f(reff[hh] - mk[(hh * 2 + 0) * NKEYMAX + T * 64 + lane]);
        if (mode != 1) wsc[(hh * 2 + 1) * 64 + lane] = __builtin_amdgcn_exp2f(refb[hh] - mk[(hh * 2 + 1) * NKEYMAX + T * 64 + lane]);
        asm volatile("s_waitcnt lgkmcnt(0)" ::: "memory");
        const float* bfp = wsc + (hh * 2 + 0) * 64 + 4 * hi; const float* bbp = wsc + (hh * 2 + 1) * 64 + 4 * hi;
        if (mode == 0) mask_pack_fact<true, true>(p0, p1, bfp, bbp, af[hh], ab[hh], pa0, pa1, pa2, pa3);
        else if (mode == 1) mask_pack_fact<true, false>(p0, p1, bfp, bbp, af[hh], ab[hh], pa0, pa1, pa2, pa3);
        else mask_pack_fact<false, true>(p0, p1, bfp, bbp, af[hh], ab[hh], pa0, pa1, pa2, pa3);
      }
      else mask_pack<true, true, true>(p0, p1, mf, mb, qf[hh], qb[hh], dqh, pa0, pa1, pa2, pa3);
#endif
      if (NH == 1) pv_d0(o, vb, pa0, pa1, pa2, pa3);
      else if (hh == 0) { pv_one<0>(o[0], vb, pa0, pa1, pa2, pa3); pv_one<1>(o[1], vb, pa0, pa1, pa2, pa3); }
      else { pv_one<2>(o[2], vb, pa0, pa1, pa2, pa3); pv_one<3>(o[3], vb, pa0, pa1, pa2, pa3); }
    }
    if (T + 2 < NT) RING_SYNC(4); else RING_SYNC(0);
    st = st == 2 ? 0 : st + 1;
  }
}
__device__ __forceinline__ void attn_body2(const bf16* __restrict__ Qb, const bf16* __restrict__ Kh, const bf16* __restrict__ Vh, int ld, int ctx_row0, int lat_row0, int NT,
                                           bf16* __restrict__ Ob, int ldo, char* lds) {
  const int tid = otid(), wid = __builtin_amdgcn_readfirstlane(tid >> 6), lane = tid & 63, r32 = lane & 31, hi = lane >> 5;
  float* ws = (float*)(lds + OFF_WS) + wid * 256; float* li_l = ws; float* al_l = ws + 32;
  float m_reg = -1e30f, l_reg = 0; f32x16 o[4] = {}; bf16x8 qr[8];
  const bf16* Qw = Qb + (long)(wid * QBLK + r32) * ld + hi * 8;
#pragma unroll
  for (int d0 = 0; d0 < 8; ++d0) qr[d0] = ld8(Qw + d0 * 16);
  int koff[2], voff[2]; dma_map(wid, lane, ld, koff, voff);
  const int vb0 = (int)(uintptr_t)lds + v_rd_base(lane);
  DMA_ISSUE(0, 0); DMA_ISSUE(1, 1);
  RING_SYNC(4);
  int st = 0;
  for (int T = 0; T < NT; ++T) {
    if (T + 2 < NT) { const int s2 = st == 0 ? 2 : st - 1; DMA_ISSUE(T + 2, s2); }
    f32x16 p0, p1; float mn, alpha; bf16x8 pa0, pa1, pa2, pa3;
    qkt_plain(p0, p1, (const bf16*)(lds + st * STAGE_B + SHM_V), qr, r32, hi);
    partialSM(p0, p1, m_reg, mn, alpha);
    finishSM(p0, p1, alpha, l_reg, pa0, pa1, pa2, pa3);
    if (__any(alpha < 1.f)) { if (hi == 0) al_l[r32] = alpha; asm volatile("s_waitcnt lgkmcnt(0)" ::: "memory");
#pragma unroll
      for (int d = 0; d < 4; ++d)
#pragma unroll
        for (int r = 0; r < 16; ++r) o[d][r] *= al_l[crow(r, hi)]; }
    pv_d0(o, vb0 + st * STAGE_B, pa0, pa1, pa2, pa3);
    if (T + 2 < NT) RING_SYNC(4); else RING_SYNC(0);
    st = st == 2 ? 0 : st + 1;
  }
  if (hi == 0) li_l[r32] = l_reg; asm volatile("s_waitcnt lgkmcnt(0)" ::: "memory");
  float rli[16];
#pragma unroll
  for (int r = 0; r < 16; ++r) rli[r] = __builtin_amdgcn_rcpf(li_l[crow(r, hi)]);
  bf16* Ow = Ob + (long)(wid * QBLK) * ldo;
#pragma unroll
  for (int r = 0; r < 16; ++r) { int orow = crow(r, hi);
#pragma unroll
    for (int d0 = 0; d0 < 4; ++d0) Ow[(long)orow * ldo + d0 * 32 + r32] = f2bf(o[d0][r] * rli[r]); }
}

#define DMA_ISSUE_K(T_, st_) do { const bf16* kb_ = Kh + tile_row((T_), ctx_row0, lat_row0) * (long)ld; \
    MXLAS unsigned char* sb_ = (MXLAS unsigned char*)lds + (st_) * STAGE_B + SHM_V + wid * 2048; \
    _Pragma("unroll") for (int i_ = 0; i_ < 2; ++i_) __builtin_amdgcn_global_load_lds((const unsigned*)(kb_ + koff[i_]), (MXLAS unsigned*)(sb_ + i_ * 1024), 16, 0, 0); } while (0)
#define DMA_ISSUE_V(T_, st_) do { const bf16* vp_ = Vh + tile_row((T_), ctx_row0, lat_row0) * (long)ld; \
    MXLAS unsigned char* sb_ = (MXLAS unsigned char*)lds + (st_) * STAGE_B + wid * 2048; \
    _Pragma("unroll") for (int i_ = 0; i_ < 2; ++i_) __builtin_amdgcn_global_load_lds((const unsigned*)(vp_ + voff[i_]), (MXLAS unsigned*)(sb_ + i_ * 1024), 16, 0, 0); } while (0)
__device__ __forceinline__ void attn_body3(const bf16* __restrict__ Qb, const bf16* __restrict__ Kh, const bf16* __restrict__ Vh, int ld, int ctx_row0, int lat_row0, int NT,
                                           bf16* __restrict__ Ob, int ldo, char* lds) {
  const int tid = otid(), wid = __builtin_amdgcn_readfirstlane(tid >> 6), lane = tid & 63, r32 = lane & 31, hi = lane >> 5;
  float* ws = (float*)(lds + OFF_WS) + wid * 256; float* li_l = ws; float* al_l = ws + 32;
  int koff[2], voff[2]; dma_map(wid, lane, ld, koff, voff);
  DMA_ISSUE_K(0, 0); DMA_ISSUE_K(1, 1); DMA_ISSUE_V(0, 0);
  DMA_ISSUE_K(2, 2); DMA_ISSUE_V(1, 1);
  float m_reg = -1e30f, l_reg = 0; f32x16 o[4] = {}; bf16x8 qr[8];
  const bf16* Qw = Qb + (long)(wid * QBLK + r32) * ld + hi * 8;
#pragma unroll
  for (int d0 = 0; d0 < 8; ++d0) qr[d0] = __builtin_nontemporal_load(reinterpret_cast<const bf16x8*>(Qw + d0 * 16));
  const int vb0 = (int)(uintptr_t)lds + v_rd_base(lane);
#define RESC3(a) do { if (__any((a) < 1.f)) { if (hi == 0) al_l[r32] = (a); asm volatile("s_waitcnt lgkmcnt(0)" ::: "memory"); \
    _Pragma("unroll") for (int d = 0; d < 4; ++d) _Pragma("unroll") for (int r = 0; r < 16; ++r) o[d][r] *= al_l[crow(r, hi)]; } } while (0)
#define HALF3(j_, X0, X1, Y0, Y1, mnX, alX, alY) do { const int jj_ = (j_); \
    if (jj_ + 2 < NT) DMA_ISSUE_K(jj_ + 2, (jj_ + 2) % 3); if (jj_ + 1 < NT) DMA_ISSUE_V(jj_ + 1, (jj_ + 1) % 3); \
    SBAR(); qkt_plain(X0, X1, (const bf16*)(lds + (jj_ % 3) * STAGE_B + SHM_V), qr, r32, hi); \
    finishSM(Y0, Y1, alY, l_reg, pa0, pa1, pa2, pa3); SBAR(); \
    pv_d0(o, vb0 + ((jj_ + 2) % 3) * STAGE_B, pa0, pa1, pa2, pa3); partialSM(X0, X1, m_reg, mnX, alX); \
    if (jj_ + 2 < NT) RING_SYNC(4); else if (jj_ + 1 < NT) RING_SYNC(2); else RING_SYNC(0); \
    RESC3(alX); } while (0)
  f32x16 pA0, pA1, pB0, pB1; float mnA, mnB, alA, alB; bf16x8 pa0, pa1, pa2, pa3;
  RING_SYNC(0);
  qkt_plain(pA0, pA1, (const bf16*)(lds + SHM_V), qr, r32, hi); partialSM(pA0, pA1, m_reg, mnA, alA);
  RING_SYNC(0);
  for (int j = 1; j + 1 < NT; j += 2) {
    HALF3(j, pB0, pB1, pA0, pA1, mnB, alB, alA);
    HALF3(j + 1, pA0, pA1, pB0, pB1, mnA, alA, alB);
  }
  HALF3(NT - 1, pB0, pB1, pA0, pA1, mnB, alB, alA);
  finishSM(pB0, pB1, alB, l_reg, pa0, pa1, pa2, pa3); SBAR();
  pv_d0(o, vb0 + ((NT - 1) % 3) * STAGE_B, pa0, pa1, pa2, pa3);
  asm volatile("s_waitcnt lgkmcnt(0)" ::: "memory"); __builtin_amdgcn_s_barrier(); asm volatile("" ::: "memory");
  if (hi == 0) li_l[r32] = l_reg; asm volatile("s_waitcnt lgkmcnt(0)" ::: "memory");
  float rli[16];
#pragma unroll
  for (int r = 0; r < 16; ++r) rli[r] = __builtin_amdgcn_rcpf(li_l[crow(r, hi)]);
  bf16* Ow = Ob + (long)(wid * QBLK) * ldo;
#pragma unroll
  for (int r = 0; r < 16; ++r) { int orow = crow(r, hi);
#pragma unroll
    for (int d0 = 0; d0 < 4; ++d0) Ow[(long)orow * ldo + d0 * 32 + r32] = f2bf(o[d0][r] * rli[r]); }
#undef HALF3
#undef RESC3
}

__device__ __forceinline__ void mask_fact1(const f32x16& p0, const f32x16& p1, const float* bk, float a, bf16x8& pa0, bf16x8& pa1, bf16x8& pa2, bf16x8& pa3) {
  float t[8];
#pragma unroll
  for (int half = 0; half < 2; ++half) {
#pragma unroll
    for (int gg = 0; gg < 2; ++gg) {
#pragma unroll
      for (int g2 = 0; g2 < 2; ++g2) { const int g = gg * 2 + g2; const f32x4 f4 = *(const f32x4*)(bk + half * 32 + 8 * g);
#pragma unroll
        for (int i = 0; i < 4; ++i) { const float s = half == 0 ? p0[4 * g + i] : p1[4 * g + i]; t[g2 * 4 + i] = s * (a * f4[i]); } }
      bf16x8 out; PK4(t, 0, out);
      if (half == 0) { if (gg == 0) pa0 = out; else pa1 = out; } else { if (gg == 0) pa2 = out; else pa3 = out; }
    }
  }
}
template <int NH>
__device__ __forceinline__ void lin_body3(const bf16* __restrict__ Qb, const bf16* __restrict__ Kh, const bf16* __restrict__ Vh, int ld, int ctx_row0, int lat_row0, int NT,
                                          const float* __restrict__ msk, int qn0, int tq0, bool latq, f32x16 (&o)[4], char* lds) {
  const int tid = otid(), wid = __builtin_amdgcn_readfirstlane(tid >> 6), lane = tid & 63, r32 = lane & 31, hi = lane >> 5;
  float* mk = (float*)(lds + OFF_MK);
  int koff[2], voff[2]; dma_map(wid, lane, ld, koff, voff);
  DMA_ISSUE_K(0, 0); DMA_ISSUE_K(1, 1); DMA_ISSUE_V(0, 0);
  DMA_ISSUE_K(2, 2); DMA_ISSUE_V(1, 1);
  bf16x8 qr[8];
#pragma unroll
  for (int d = 0; d < 4; ++d) o[d] = f32x16{};
  const bf16* Qw = Qb + (long)(wid * QBLK + r32) * ld + hi * 8;
#pragma unroll
  for (int d0 = 0; d0 < 8; ++d0) qr[d0] = __builtin_nontemporal_load(reinterpret_cast<const bf16x8*>(Qw + d0 * 16));
  { float tmpm[NH * 9];
#pragma unroll
    for (int it = 0; it < NH * 9; ++it) { const int i = it * 512 + tid, a = i / NKEYMAX, n = i - a * NKEYMAX; tmpm[it] = msk[(size_t)((a >> 1) * 4 + 1 + 2 * (a & 1)) * NKEYMAX + n]; }
#pragma unroll
    for (int it = 0; it < NH * 9; ++it) { const int i = it * 512 + tid; mk[i] = tmpm[it]; } }
  float qf[NH], qb[NH];
#pragma unroll
  for (int hh = 0; hh < NH; ++hh) { const int nq = qn0 + wid * QBLK + r32; qf[hh] = msk[(size_t)(hh * 4 + 0) * NKEYMAX + nq]; qb[hh] = msk[(size_t)(hh * 4 + 2) * NKEYMAX + nq]; }
  const int tw0 = tq0 + wid * QBLK;
  float reff[NH], refb[NH], af[NH], ab[NH];
#pragma unroll
  for (int hh = 0; hh < NH; ++hh) { reff[hh] = __shfl(qf[hh], 0); refb[hh] = __shfl(qb[hh], 31);
    af[hh] = __builtin_amdgcn_exp2f(qf[hh] - reff[hh]); ab[hh] = __builtin_amdgcn_exp2f(qb[hh] - refb[hh]); }
  float* wsc = (float*)(lds + OFF_WS) + wid * 256;
  const int vb0 = (int)(uintptr_t)lds + v_rd_base(lane);
#define LMASK(T_, hh_, Y0, Y1, QKT_) do { const int Tm_ = (T_); int mode_, s0_ = 0; \
    if (latq && Tm_ < 4) mode_ = 0; else { s0_ = 64 * (Tm_ - (latq ? 4 : 0)); mode_ = (s0_ + 63 < tw0) ? 1 : ((s0_ > tw0 + 31) ? 2 : 3); } \
    if (mode_ == 1 || mode_ == 2) { const int dsel_ = mode_ - 1; \
      wsc[(hh_) * 64 + lane] = __builtin_amdgcn_exp2f((dsel_ ? refb[hh_] : reff[hh_]) - mk[((hh_) * 2 + dsel_) * NKEYMAX + Tm_ * 64 + lane]); \
      asm volatile("s_waitcnt lgkmcnt(0)" ::: "memory"); SBAR(); \
      QKT_; mask_fact1(Y0, Y1, wsc + (hh_) * 64 + 4 * hi, dsel_ ? ab[hh_] : af[hh_], pa0, pa1, pa2, pa3); SBAR(); } \
    else if (mode_ == 0) { \
      wsc[(hh_) * 64 + lane] = __builtin_amdgcn_exp2f(reff[hh_] - mk[((hh_) * 2 + 0) * NKEYMAX + Tm_ * 64 + lane]); \
      wsc[128 + (hh_) * 64 + lane] = __builtin_amdgcn_exp2f(refb[hh_] - mk[((hh_) * 2 + 1) * NKEYMAX + Tm_ * 64 + lane]); \
      asm volatile("s_waitcnt lgkmcnt(0)" ::: "memory"); \
      QKT_; mask_pack_fact<true, true>(Y0, Y1, wsc + (hh_) * 64 + 4 * hi, wsc + 128 + (hh_) * 64 + 4 * hi, af[hh_], ab[hh_], pa0, pa1, pa2, pa3); } \
    else { int dqh_ = tw0 + r32 - s0_ - 4 * hi; asm volatile("" : "+v"(dqh_)); \
      QKT_; mask_pack<true, true, true>(Y0, Y1, mk + ((hh_) * 2 + 0) * NKEYMAX + Tm_ * 64 + 4 * hi, mk + ((hh_) * 2 + 1) * NKEYMAX + Tm_ * 64 + 4 * hi, qf[hh_], qb[hh_], dqh_, pa0, pa1, pa2, pa3); } } while (0)
#define LPV(T_, Y0, Y1, QKT_) do { const int vb_ = vb0 + ((T_) % 3) * STAGE_B; \
    LMASK(T_, 0, Y0, Y1, QKT_); \
    if (NH == 1) pv_d0(o, vb_, pa0, pa1, pa2, pa3); \
    else { pv_one<0>(o[0], vb_, pa0, pa1, pa2, pa3); pv_one<1>(o[1], vb_, pa0, pa1, pa2, pa3); \
      LMASK(T_, NH - 1, Y0, Y1, (void)0); \
      pv_one<2>(o[2], vb_, pa0, pa1, pa2, pa3); pv_one<3>(o[3], vb_, pa0, pa1, pa2, pa3); } } while (0)
#define HALFL(j_, X0, X1, Y0, Y1) do { const int jj_ = (j_); \
    if (jj_ + 2 < NT) DMA_ISSUE_K(jj_ + 2, (jj_ + 2) % 3); if (jj_ + 1 < NT) DMA_ISSUE_V(jj_ + 1, (jj_ + 1) % 3); \
    LPV(jj_ - 1, Y0, Y1, qkt_plain(X0, X1, (const bf16*)(lds + (jj_ % 3) * STAGE_B + SHM_V), qr, r32, hi)); \
    if (jj_ + 2 < NT) RING_SYNC(4); else if (jj_ + 1 < NT) RING_SYNC(2); else RING_SYNC(0); } while (0)
  f32x16 pA0, pA1, pB0, pB1; bf16x8 pa0, pa1, pa2, pa3;
  RING_SYNC(0);
  qkt_plain(pA0, pA1, (const bf16*)(lds + SHM_V), qr, r32, hi);
  RING_SYNC(0);
  for (int j = 1; j + 1 < NT; j += 2) {
    HALFL(j, pB0, pB1, pA0, pA1);
    HALFL(j + 1, pA0, pA1, pB0, pB1);
  }
  HALFL(NT - 1, pB0, pB1, pA0, pA1);
  LPV(NT - 1, pB0, pB1, (void)0);
  asm volatile("s_waitcnt lgkmcnt(0)" ::: "memory"); __builtin_amdgcn_s_barrier(); asm volatile("" ::: "memory");
#undef HALFL
#undef LPV
#undef LMASK
}
__device__ __forceinline__ void SBAR_() { __builtin_amdgcn_sched_barrier(0); }
#undef PK4
}
#define LAS __attribute__((address_space(3)))
typedef unsigned short bf16_t;
typedef float f32x4 __attribute__((ext_vector_type(4)));
typedef unsigned u32x4 __attribute__((ext_vector_type(4)));
typedef unsigned u32x2 __attribute__((ext_vector_type(2)));
constexpr int DM = 2048, NBATCH = 8, SEQ = 2048, CTXL = 256;
constexpr int MLAT = NBATCH * SEQ, MCTX = NBATCH * CTXL, MTOT = MLAT + MCTX;
constexpr int DIN = 5400, DINP = 5632, DFF = 5632;
constexpr int C_AQ = 0, C_AK = 768, C_AV = 1024, C_RQ = 1280, C_RK = 1792, C_RV = 2304, C_RG = 2816, C_Z = 3328, C_XBC = 4096, C_DT = 5376;
constexpr int CVW = 1280, NKEY = 2304;
constexpr float EPSN = 1e-6f, LOG2E = 1.4426950408889634f;
constexpr size_t MiB = (size_t)1 << 20;
constexpr size_t WS_BAR = (size_t)1 << 20;
constexpr size_t WS_ROPE = 0, WS_MOD = 65536, WS_MODP = 2 * MiB, WS_WIN = 16 * MiB, WS_WOUT = 60 * MiB, WS_WGU = 76 * MiB, WS_WD = 164 * MiB,
                 WS_ACT = 208 * MiB, WS_PROJ = 280 * MiB, WS_CV = 478 * MiB, WS_MF = 523 * MiB, WS_XC = 595 * MiB, WS_MASK = 611 * MiB, WS_DT = 616 * MiB, WS_XB = 618 * MiB, WS_END = 690 * MiB;
constexpr int LDS_BYTES = 147456;
enum { I_X = 0, I_C, I_CTX, I_CCTX, I_WMOD, I_BMOD, I_PREMIX, I_POSTMIX, I_PREFFN, I_POSTFFN, I_WIN, I_QG, I_KG, I_RDF, I_RDB, I_CONVW, I_CONVB, I_DTBF, I_DTBB,
       I_ALF, I_ALB, I_DSKIP, I_SSDG, I_WOUT, I_WGATE, I_WUP, I_WDOWN, N_IN };
struct KArgs { const float* in[N_IN]; float* out; unsigned char* ws; int ph_lo, ph_hi; };

__device__ __forceinline__ float wave_sum(float v) {
#pragma unroll
    for (int o = 1; o < 64; o <<= 1) v += __shfl_xor(v, o);
    return v; }
__device__ __forceinline__ float bflo(unsigned w) { return __uint_as_float(w << 16); }
__device__ __forceinline__ float bfhi(unsigned w) { return __uint_as_float(w & 0xffff0000u); }
__device__ __forceinline__ unsigned pkbf(float lo, float hi) { return pg8::cvt_pk_bf16(lo, hi); }
__device__ __forceinline__ float silu_acc(float x) { return x / (1.0f + expf(-x)); }
__device__ __forceinline__ float softplus_f(float x) { return x > 20.f ? x : log1pf(expf(x)); }
__device__ __forceinline__ float softplus_hw(float x) {
    const float u = __builtin_amdgcn_exp2f(-fabsf(x) * 1.4426950408889634f);
    const float small = u * (1.0f + u * (-0.5f + u * (0.33333334f - 0.25f * u)));
    const float big = __builtin_amdgcn_logf(1.0f + u) * 0.6931471805599453f;
    return fmaxf(x, 0.f) + (u < 0.03125f ? small : big);
}

#define RSBAR() __builtin_amdgcn_sched_barrier(0)
__device__ __forceinline__ void transpose_item(const float* __restrict__ W, int K, int N, int nblk, bf16_t* __restrict__ WT, int mode, float* scr, int item, int lane) {
    const int kb = item / nblk, nb = item - kb * nblk, k0 = 64 * kb, n0 = 32 * nb, n = n0 + (lane & 31);
    float tv[32];
    RSBAR();
#pragma unroll
    for (int i = 0; i < 32; ++i) { const int kk = 2 * i + (lane >> 5); tv[i] = (n < N) ? __builtin_nontemporal_load(W + (size_t)(k0 + kk) * N + n) : 0.f; }
    RSBAR();
#pragma unroll
    for (int i = 0; i < 32; ++i) { const int kk = 2 * i + (lane >> 5); scr[kk * 33 + (lane & 31)] = tv[i]; }
    asm volatile("s_waitcnt lgkmcnt(0)" ::: "memory");
    const int c = lane & 7;
    const int drow0 = (mode == 0) ? n0 : (256 * (n0 >> 7) + (n0 & 127) + (mode == 2 ? 128 : 0));
#pragma unroll
    for (int j = 0; j < 4; ++j) { const int nn = (lane >> 3) + 8 * j; const float* s = scr + (8 * c) * 33 + nn;
        u32x4 o; o.x = pkbf(s[0 * 33], s[1 * 33]); o.y = pkbf(s[2 * 33], s[3 * 33]); o.z = pkbf(s[4 * 33], s[5 * 33]); o.w = pkbf(s[6 * 33], s[7 * 33]);
        *(u32x4*)(WT + (size_t)(drow0 + nn) * K + k0 + 8 * c) = o; }
    asm volatile("s_waitcnt lgkmcnt(0)" ::: "memory");
}

template <bool XIN16, bool XOUT16>
__device__ __forceinline__ void row_op(const float* __restrict__ xin, const bf16_t* xin16, const bf16_t* __restrict__ add, const float* __restrict__ gate,
                                       float* __restrict__ xout, bf16_t* xout16,
                                       const float* __restrict__ sc, const float* __restrict__ sh, bf16_t* __restrict__ hout, int lane) {
    f32x4 v[8]; u32x2 xw[8];
    if (add != nullptr) {
        u32x2 aw[8]; f32x4 g[8];
        RSBAR();
#pragma unroll
        for (int j = 0; j < 8; ++j) { if (XIN16) xw[j] = __builtin_nontemporal_load((const u32x2*)(xin16 + j * 256 + lane * 4)); else v[j] = __builtin_nontemporal_load((const f32x4*)(xin + j * 256 + lane * 4)); aw[j] = __builtin_nontemporal_load((const u32x2*)(add + j * 256 + lane * 4)); }
#pragma unroll
        for (int j = 0; j < 8; ++j) g[j] = *(const f32x4*)(gate + j * 256 + lane * 4);
        RSBAR();
        if (XIN16) {
#pragma unroll
            for (int j = 0; j < 8; ++j) v[j] = (f32x4){bflo(xw[j].x), bfhi(xw[j].x), bflo(xw[j].y), bfhi(xw[j].y)};
        }
        f32x4 a[8]; float ss = 0.f;
#pragma unroll
        for (int j = 0; j < 8; ++j) { a[j] = (f32x4){bflo(aw[j].x), bfhi(aw[j].x), bflo(aw[j].y), bfhi(aw[j].y)};
            ss += (a[j].x * a[j].x + a[j].y * a[j].y) + (a[j].z * a[j].z + a[j].w * a[j].w); }
        const float rstd = rsqrtf(wave_sum(ss) * (1.f / DM) + EPSN);
#pragma unroll
        for (int j = 0; j < 8; ++j) v[j] = v[j] + g[j] * (a[j] * rstd);
    } else {
        RSBAR();
#pragma unroll
        for (int j = 0; j < 8; ++j) { if (XIN16) xw[j] = __builtin_nontemporal_load((const u32x2*)(xin16 + j * 256 + lane * 4)); else v[j] = __builtin_nontemporal_load((const f32x4*)(xin + j * 256 + lane * 4)); }
        RSBAR();
        if (XIN16) {
#pragma unroll
            for (int j = 0; j < 8; ++j) v[j] = (f32x4){bflo(xw[j].x), bfhi(xw[j].x), bflo(xw[j].y), bfhi(xw[j].y)};
        }
    }
    if (XOUT16) {
#pragma unroll
        for (int j = 0; j < 8; ++j) { u32x2 w; w.x = pkbf(v[j].x, v[j].y); w.y = pkbf(v[j].z, v[j].w); xw[j] = w; }
    }
    if (hout != nullptr) {
        f32x4 s[8], h[8];
        RSBAR();
#pragma unroll
        for (int j = 0; j < 8; ++j) { s[j] = *(const f32x4*)(sc + j * 256 + lane * 4); h[j] = *(const f32x4*)(sh + j * 256 + lane * 4); }
        RSBAR();
        if (XOUT16) {
#pragma unroll
            for (int j = 0; j < 8; ++j) __builtin_nontemporal_store(xw[j], (u32x2*)(xout16 + j * 256 + lane * 4));
        } else if (xout != nullptr) {
#pragma unroll
            for (int j = 0; j < 8; ++j) __builtin_nontemporal_store(v[j], (f32x4*)(xout + j * 256 + lane * 4));
        }
        float ss = 0.f;
#pragma unroll
        for (int j = 0; j < 8; ++j) ss += (v[j].x * v[j].x + v[j].y * v[j].y) + (v[j].z * v[j].z + v[j].w * v[j].w);
        const float rstd = rsqrtf(wave_sum(ss) * (1.f / DM) + EPSN);
#pragma unroll
        for (int j = 0; j < 8; ++j) { const f32x4 y = (v[j] * rstd) * s[j] + h[j]; u32x2 w; w.x = pkbf(y.x, y.y); w.y = pkbf(y.z, y.w); *(u32x2*)(hout + j * 256 + lane * 4) = w; }
    } else if (XOUT16) {
#pragma unroll
        for (int j = 0; j < 8; ++j) __builtin_nontemporal_store(xw[j], (u32x2*)(xout16 + j * 256 + lane * 4));
    } else if (xout != nullptr) {
#pragma unroll
        for (int j = 0; j < 8; ++j) __builtin_nontemporal_store(v[j], (f32x4*)(xout + j * 256 + lane * 4));
    }
}
__device__ __forceinline__ const float* mod_vec(const float* MOD, int l, int row, int chunk) { const int r = row < MLAT ? row / SEQ : 8; return MOD + ((size_t)(l * 9 + r) * 6 + chunk) * DM; }

__device__ __forceinline__ unsigned rope_pair(unsigned w, float m0, float m1, float cs, float sn) {
    const float x1 = bflo(w) * m0, x2 = bfhi(w) * m1; return pkbf(x1 * cs - x2 * sn, x1 * sn + x2 * cs); }
template <int NR>
__device__ __forceinline__ void prep_rows(bf16_t* __restrict__ PROJ, const int (&rows)[NR], const float* __restrict__ ROPE, const float* __restrict__ qg, const float* __restrict__ kg, int lane) {
    float cs[NR], sn[NR]; unsigned* p[NR]; unsigned w[NR][16];
    const float qg0 = qg[2 * lane], qg1 = qg[2 * lane + 1], kg0 = kg[2 * lane], kg1 = kg[2 * lane + 1];
#pragma unroll
    for (int q = 0; q < NR; ++q) { const int row = rows[q]; cs[q] = 1.f; sn[q] = 0.f; p[q] = (unsigned*)(PROJ + (size_t)row * DINP);
        if (row < MLAT) { const int t = row & (SEQ - 1), pos = lane < 32 ? (t >> 6) : (t & 63), f = lane & 31; cs[q] = ROPE[(pos * 32 + f) * 2]; sn[q] = ROPE[(pos * 32 + f) * 2 + 1]; }
#pragma unroll
        for (int h = 0; h < 8; ++h) w[q][h] = p[q][h * 64 + lane];
#pragma unroll
        for (int h = 0; h < 4; ++h) { w[q][8 + h] = p[q][C_RQ / 2 + h * 64 + lane]; w[q][12 + h] = p[q][C_RK / 2 + h * 64 + lane]; } }
#pragma unroll
    for (int q = 0; q < NR; ++q) {
        float ss[8];
#pragma unroll
        for (int h = 0; h < 8; ++h) { const float x1 = bflo(w[q][h]), x2 = bfhi(w[q][h]); ss[h] = x1 * x1 + x2 * x2; }
#pragma unroll
        for (int o = 1; o < 64; o <<= 1) {
#pragma unroll
            for (int h = 0; h < 8; ++h) ss[h] += __shfl_xor(ss[h], o); }
#pragma unroll
        for (int h = 0; h < 8; ++h) { const float rstd = rsqrtf(ss[h] * (1.f / 128.f) + EPSN); w[q][h] = rope_pair(w[q][h], rstd * (h < 6 ? qg0 : kg0), rstd * (h < 6 ? qg1 : kg1), cs[q], sn[q]); }
#pragma unroll
        for (int h = 0; h < 4; ++h) { w[q][8 + h] = rope_pair(w[q][8 + h], 1.f, 1.f, cs[q], sn[q]); w[q][12 + h] = rope_pair(w[q][12 + h], 0.08838834764831845f, 0.08838834764831845f, cs[q], sn[q]); }
#pragma unroll
        for (int h = 0; h < 8; ++h) p[q][h * 64 + lane] = w[q][h];
#pragma unroll
        for (int h = 0; h < 4; ++h) { p[q][C_RQ / 2 + h * 64 + lane] = w[q][8 + h]; p[q][C_RK / 2 + h * 64 + lane] = w[q][12 + h]; } }
}
__device__ __forceinline__ unsigned ld_u(const bf16_t* PROJ, int row, int S0, int S1, int ch) { return (row >= S0 && row < S1) ? __builtin_nontemporal_load((const unsigned*)(PROJ + (size_t)row * DINP + C_XBC + ch)) : 0u; }
#define XB_TMO      128
#define XB_XCNT(j)  (256  + 64 * (j))
#define XB_XSUB(j)  (1280 + 64 * (j))
#define XB_XGEN(j)  (2304 + 64 * (j))
#define XB_TOP      3328
#define XB_TOPGEN   3392
#define XCD_BAR_WORDS 3456
#define XB_SPIN_CAP (1u << 18)

__device__ __forceinline__ unsigned xb_ld(unsigned* p)              { return __hip_atomic_load(p, __ATOMIC_RELAXED, __HIP_MEMORY_SCOPE_AGENT); }
__device__ __forceinline__ unsigned xb_add(unsigned* p, unsigned v) { return __hip_atomic_fetch_add(p, v, __ATOMIC_RELAXED, __HIP_MEMORY_SCOPE_AGENT); }
__device__ __forceinline__ unsigned xb_xcc_id() { return (unsigned)__builtin_amdgcn_s_getreg((3 << 11) | 20) & 0xFu; }
#define XB_SPIN(cond, bar) do { unsigned _sp = 0; while (cond) { __builtin_amdgcn_s_sleep(1); \
    if ((++_sp & 255u) == 0u) { if (xb_ld(&(bar)[XB_TMO])) break; if (_sp > XB_SPIN_CAP) { atomicAdd(&(bar)[XB_TMO], 1u); break; } } } } while (0)

struct XcdBarrier {
    unsigned* bar; unsigned x;
    volatile LAS unsigned* st;
};

__device__ __forceinline__ XcdBarrier xcd_barrier_post(unsigned* bar, volatile LAS unsigned* st) {
    XcdBarrier b; b.bar = bar; b.x = xb_xcc_id(); b.st = st;
    if (threadIdx.x == 0) (void)xb_add(&bar[XB_XCNT(b.x)], 1u);
    return b;
}
__device__ __forceinline__ void xcd_barrier_complete(unsigned* bar, unsigned x, unsigned& nloc, unsigned& nx) {
    const unsigned G = gridDim.x * gridDim.y * gridDim.z;
    unsigned sum, cnt, mine, sp = 0u;
    for (;;) {
        sum = 0u; cnt = 0u; mine = 0u;
#pragma unroll
        for (unsigned j = 0; j < 16; ++j) { const unsigned c = xb_ld(&bar[XB_XCNT(j)]); sum += c; cnt += (c > 0u) ? 1u : 0u; mine = (j == x) ? c : mine; }
        if (sum == G) break;
        __builtin_amdgcn_s_sleep(1);
        if ((++sp & 255u) == 0u) { if (xb_ld(&bar[XB_TMO])) break; if (sp > XB_SPIN_CAP) { atomicAdd(&bar[XB_TMO], 1u); break; } }
    }
    nloc = mine > 0u ? mine : 1u; nx = cnt > 0u ? cnt : 1u;
}

__device__ __forceinline__ void xcd_barrier(const XcdBarrier& b) {
    asm volatile("s_waitcnt vmcnt(0)" ::: "memory");
    __syncthreads();
    if (threadIdx.x == 0) {
        unsigned* bar = b.bar;
        __builtin_amdgcn_s_waitcnt(0);
        unsigned nloc = b.st[0], nx = b.st[1];
        if (nloc == 0u) { xcd_barrier_complete(bar, b.x, nloc, nx); b.st[0] = nloc; b.st[1] = nx; }
        const unsigned old = xb_add(&bar[XB_XSUB(b.x)], 1u);
        const unsigned gen = old / nloc;
        if (old + 1u == (gen + 1u) * nloc) {
            __builtin_amdgcn_fence(__ATOMIC_RELEASE, "agent");
            asm volatile("s_waitcnt vmcnt(0)" ::: "memory");
            const unsigned og = xb_add(&bar[XB_TOP], 1u);
            const unsigned tg = og / nx;
            if (og + 1u == (tg + 1u) * nx) xb_add(&bar[XB_TOPGEN], 1u);
            else XB_SPIN(xb_ld(&bar[XB_TOPGEN]) == tg, bar);
            __builtin_amdgcn_fence(__ATOMIC_ACQUIRE, "agent");
            xb_add(&bar[XB_XGEN(b.x)], 1u);
            asm volatile("s_waitcnt vmcnt(0)" ::: "memory");
        } else {
            XB_SPIN(xb_ld(&bar[XB_XGEN(b.x)]) == gen, bar);
            __builtin_amdgcn_fence(__ATOMIC_ACQUIRE, "agent");
            asm volatile("s_waitcnt vmcnt(0)" ::: "memory");
        }
    }
    __syncthreads();
}

#ifndef TAILCUT
#define TAILCUT 5632
#endif
#ifndef MK_PER_PHASE
#define MK_PER_PHASE 0
#endif
constexpr int NPHASE = 3 + 2 * 9;
__global__ void __launch_bounds__(512, 2) hybrid_fwd(KArgs a) {
    extern __shared__ __attribute__((aligned(16))) unsigned char lds[];
    cg::grid_group grid = cg::this_grid();
    volatile LAS unsigned* bst = (volatile LAS unsigned*)((LAS unsigned char*)lds + LDS_BYTES - 64);
    if (threadIdx.x < 2) bst[threadIdx.x] = 0u;
    __syncthreads();
    XcdBarrier xbar = xcd_barrier_post((unsigned*)(a.ws + WS_BAR), bst);
    const int G = gridDim.x, NGW = G * 8; const long GT = (long)G * 512;
#define PH_VARS() const int tid = otid(), lane = tid & 63, wid = __builtin_amdgcn_readfirstlane(tid >> 6), gw = blockIdx.x * 8 + wid; const long gtid = (long)blockIdx.x * 512 + tid; (void)lane; (void)gw; (void)gtid; \
    int zq = 0; asm volatile("" : "+s"(zq)); unsigned char* ws = (unsigned char*)(__attribute__((address_space(1))) unsigned char*)a.ws + zq; \
    float* ROPE = (float*)(ws + WS_ROPE); float* MOD = (float*)(ws + WS_MOD); float* MODP = (float*)(ws + WS_MODP); \
    bf16_t* WIN_T = (bf16_t*)(ws + WS_WIN); bf16_t* WOUT_T = (bf16_t*)(ws + WS_WOUT); bf16_t* WGU_T = (bf16_t*)(ws + WS_WGU); bf16_t* WD_T = (bf16_t*)(ws + WS_WD); \
    bf16_t* ACT = (bf16_t*)(ws + WS_ACT); bf16_t* PROJ = (bf16_t*)(ws + WS_PROJ); bf16_t* CV = (bf16_t*)(ws + WS_CV); bf16_t* MF = (bf16_t*)(ws + WS_MF); \
    float* XC = (float*)(ws + WS_XC); float* MASK = (float*)(ws + WS_MASK); float* DT = (float*)(ws + WS_DT); bf16_t* XB = (bf16_t*)(ws + WS_XB); (void)XB; float* OUTP = (float*)((__attribute__((address_space(1))) float*)a.out + zq); \
    (void)ROPE; (void)MOD; (void)MODP; (void)WIN_T; (void)WOUT_T; (void)WGU_T; (void)WD_T; (void)ACT; (void)PROJ; (void)CV; (void)MF; (void)XC; (void)MASK; (void)DT; (void)OUTP;
#define INP(i) ((const float*)(__attribute__((address_space(1))) const float*)a.in[(i) + zq])
    int phase = 0; bool dup_l0 = false; (void)dup_l0;
#ifndef PHMASK
#define PHMASK 0xFFF
#endif
#ifndef ATTN_BODY
#define ATTN_BODY attn_body3
#endif
#ifndef LIN_BODY
#define LIN_BODY lin_body3
#endif
#ifndef MIXMASK
#define MIXMASK 7
#endif
#ifndef MIXDUP
#define MIXDUP 0
#endif
#define MIX_DUP(n) (((MIXDUP) >> (n)) & 1)
#define MIX_EN(n) (((MIXMASK) >> (n)) & 1)
#ifndef DUPMASK
#define DUPMASK 0
#endif
#ifndef DUP0MASK
#define DUP0MASK 0
#endif
#define PH_DUP(n) ((((DUPMASK) >> (n)) & 1) + ((((DUP0MASK) >> (n)) & 1) && dup_l0))
#define PH_EN(n) (((PHMASK) >> (n)) & 1)
#define IN_PH() (a.ph_lo <= phase && phase < a.ph_hi)
#define END_PH() do { if (a.ph_lo <= phase && phase + 1 < a.ph_hi) { if (a.ph_lo < 0) grid.sync(); else { XcdBarrier xb2_ = xbar; asm volatile("" : "+s"(xb2_.bar), "+s"(xb2_.x)); xcd_barrier(xb2_); } } ++phase; } while (0)

#define CONVERT_ITEMS(lo_, hi_, w0_, nw_) do { float* scr_ = (float*)lds + wid * 4096; \
    for (int it_ = (lo_) + (w0_); it_ < (hi_); it_ += (nw_)) { const int cl_ = it_ / 24576; int r_ = it_ - cl_ * 24576; \
        if (r_ < 5632) { transpose_item(INP(I_WIN) + (size_t)cl_ * DM * DIN, DM, DIN, 176, WIN_T + (size_t)cl_ * DINP * DM, 0, scr_, r_, lane); continue; } r_ -= 5632; \
        if (r_ < 2048) { transpose_item(INP(I_WOUT) + (size_t)cl_ * DM * DM, DM, DM, 64, WOUT_T + (size_t)cl_ * DM * DM, 0, scr_, r_, lane); continue; } r_ -= 2048; \
        if (r_ < 5632) { transpose_item(INP(I_WGATE) + (size_t)cl_ * DM * DFF, DM, DFF, 176, WGU_T + (size_t)cl_ * 2 * DFF * DM, 1, scr_, r_, lane); continue; } r_ -= 5632; \
        if (r_ < 5632) { transpose_item(INP(I_WUP) + (size_t)cl_ * DM * DFF, DM, DFF, 176, WGU_T + (size_t)cl_ * 2 * DFF * DM, 2, scr_, r_, lane); continue; } r_ -= 5632; \
        transpose_item(INP(I_WDOWN) + (size_t)cl_ * DFF * DM, DFF, DM, 64, WD_T + (size_t)cl_ * DM * DFF, 0, scr_, r_, lane); } } while (0)
    if (PH_EN(0) && IN_PH()) for (int rep_ = 0; rep_ < 1 + PH_DUP(0); ++rep_) { if (rep_) __syncthreads(); PH_VARS();
        CONVERT_ITEMS(0, 5632, gw, NGW); CONVERT_ITEMS(TAILCUT, 49152, gw, NGW);
        __syncthreads();
        float* sl = (float*)lds;
        for (int it = blockIdx.x; it < 2 * 16 * 24; it += G) {
            const int l = it / 384, r2 = it - l * 384, kc = r2 / 24, cb = r2 - kc * 24;
            for (int i = tid; i < 9 * 128; i += 512) { const int r = i >> 7, k = i & 127; const float cv = r < 8 ? INP(I_C)[r * DM + kc * 128 + k] : INP(I_CCTX)[kc * 128 + k]; sl[i] = silu_acc(cv); }
            __syncthreads();
            const int n = cb * 512 + tid; const float* wp = INP(I_WMOD) + ((size_t)l * DM + kc * 128) * 12288 + n;
            float acc[9];
#pragma unroll
            for (int r = 0; r < 9; ++r) acc[r] = 0.f;
            for (int k0 = 0; k0 < 128; k0 += 16) { float wv[16];
#pragma unroll
                for (int k = 0; k < 16; ++k) wv[k] = __builtin_nontemporal_load(wp + (size_t)(k0 + k) * 12288);
#pragma unroll
                for (int k = 0; k < 16; ++k) {
#pragma unroll
                    for (int r = 0; r < 9; ++r) acc[r] += sl[r * 128 + k0 + k] * wv[k]; } }
#pragma unroll
            for (int r = 0; r < 9; ++r) MODP[((size_t)(kc * 2 + l) * 9 + r) * 12288 + n] = acc[r];
            __syncthreads();
        }
        for (long i = gtid; i < 2048; i += GT) { const int pos = (int)i >> 5, f = (int)i & 31; const float inv = powf(10000.f, -(float)f * (1.f / 32.f)); const float ang = (float)pos * inv;
            ROPE[2 * i] = cosf(ang); ROPE[2 * i + 1] = sinf(ang); }
    }
    END_PH();
    if (PH_EN(1) && IN_PH()) for (int rep_ = 0; rep_ < 1 + PH_DUP(1); ++rep_) { if (rep_) __syncthreads(); PH_VARS();
        for (long i = gtid; i < 2 * 9 * 12288; i += GT) { const int l = (int)(i / (9 * 12288)), rem = (int)(i - (long)l * 9 * 12288), r = rem / 12288, n = rem - r * 12288;
            float s = INP(I_BMOD)[l * 12288 + n];
#pragma unroll
            for (int kc = 0; kc < 16; ++kc) s += MODP[((size_t)(kc * 2 + l) * 9 + r) * 12288 + n];
            const int ch_ = n >> 11, k_ = n & 2047;
            if (ch_ == 1) s = (1.0f + s) * INP(I_PREMIX)[l * DM + k_]; else if (ch_ == 2) s = s * INP(I_POSTMIX)[l * DM + k_];
            else if (ch_ == 4) s = (1.0f + s) * INP(I_PREFFN)[l * DM + k_]; else if (ch_ == 5) s = s * INP(I_POSTFFN)[l * DM + k_];
            MOD[i] = s; }
    }
    END_PH();
#ifdef EXTRA_SYNCS
    for (int es_ = 0; es_ < EXTRA_SYNCS; ++es_) xcd_barrier(xbar);
#endif
    if (PH_EN(2) && IN_PH()) for (int rep_ = 0; rep_ < 1 + PH_DUP(2); ++rep_) { if (rep_) __syncthreads(); PH_VARS();
        for (int row = gw; row < MTOT; row += NGW) {
            const float* xin = row < MLAT ? INP(I_X) + (size_t)row * DM : INP(I_CTX) + (size_t)(row - MLAT) * DM;
            row_op<false, false>(xin, nullptr, nullptr, nullptr, nullptr, nullptr, mod_vec(MOD, 0, row, 1), mod_vec(MOD, 0, row, 0), ACT + (size_t)row * DM, lane);
        }
    }
    END_PH();

    for (int l_it = 0; l_it < 2; ++l_it) {
        int l = l_it; asm volatile("" : "+s"(l));
        const int Mcur = (l == 1) ? MLAT : MTOT; dup_l0 = (l == 0);
        if (PH_EN(3) && IN_PH()) for (int rep_ = 0; rep_ < 1 + PH_DUP(3); ++rep_) { if (rep_) __syncthreads(); PH_VARS();
            pg8::Gemm g{ACT, WIN_T + (size_t)l * DINP * DM, MTOT, DINP, DM}; pg8::InprojOrder S; S.init(G, (int)blockIdx.x, l);
            pg8::EpiStore E{PROJ, DINP, DT, C_DT / 256};
            pg8::gemm_phase<pg8::EpiStore, pg8::InprojOrder, true, true>((PG8_LAS unsigned char*)lds, g, S, E);
            if (l == 0) {
                const int nb_ = (1584 - 6 * G > 0 && 1584 - 6 * G < G) ? 1584 - 6 * G : 0;
                if (TAILCUT > 5632 && (int)blockIdx.x >= nb_) CONVERT_ITEMS(5632, (TAILCUT < 18944 ? TAILCUT : 18944), ((int)blockIdx.x - nb_) * 8 + wid, (G - nb_) * 8);
            }
        }
        END_PH();
        if (PH_EN(4) && IN_PH()) for (int rep_ = 0; rep_ < 1 + PH_DUP(4); ++rep_) { if (rep_) __syncthreads(); PH_VARS();
            const float* qg = INP(I_QG) + l * 128; const float* kg = INP(I_KG) + l * 128;
            if (rep_ == 0) for (int row = gw; row < MTOT; row += 3 * NGW) {
                if (row + 2 * NGW < MTOT) { const int rows[3] = {row, row + NGW, row + 2 * NGW}; prep_rows<3>(PROJ, rows, ROPE, qg, kg, lane); }
                else { for (int r2 = row; r2 < MTOT; r2 += NGW) { const int rows[1] = {r2}; prep_rows<1>(PROJ, rows, ROPE, qg, kg, lane); } } }
            const float* cw = INP(I_CONVW) + (size_t)l * 5 * CVW; const float* cbias = INP(I_CONVB) + (size_t)l * CVW;
            for (int u = gw; u < (MTOT / 32) * 10; u += NGW) {
                const int rc = u / 10, cgp = u - rc * 10, r0 = rc * 32, ch = cgp * 128 + 2 * lane;
                int S0, S1; if (r0 < MLAT) { S0 = r0 & ~(SEQ - 1); S1 = S0 + SEQ; } else { S0 = MLAT + ((r0 - MLAT) & ~(CTXL - 1)); S1 = S0 + CTXL; }
                float w0[5], w1[5];
#pragma unroll
                for (int k = 0; k < 5; ++k) { w0[k] = cw[k * CVW + ch]; w1[k] = cw[k * CVW + ch + 1]; }
                const float b0 = cbias[ch], b1 = cbias[ch + 1];
                unsigned uw[36];
#pragma unroll
                for (int i = 0; i < 36; ++i) uw[i] = ld_u(PROJ, r0 - 2 + i, S0, S1, ch);
#pragma unroll
                for (int i = 0; i < 32; ++i) { const int row = r0 + i;
                    const float y0 = b0 + w0[0] * bflo(uw[i]) + w0[1] * bflo(uw[i + 1]) + w0[2] * bflo(uw[i + 2]) + w0[3] * bflo(uw[i + 3]) + w0[4] * bflo(uw[i + 4]);
                    const float y1 = b1 + w1[0] * bfhi(uw[i]) + w1[1] * bfhi(uw[i + 1]) + w1[2] * bfhi(uw[i + 2]) + w1[3] * bfhi(uw[i + 3]) + w1[4] * bfhi(uw[i + 4]);
                    *(unsigned*)(CV + (size_t)row * CVW + ch) = pkbf(pg8::silu_f(y0), pg8::silu_f(y1)); }
            }
            for (int u = gw; u < NBATCH * 24; u += NGW) {
                const int b = u / 24, rem = u - b * 24, dir = rem / 12, h = rem - dir * 12;
                const float bias = INP(dir ? I_DTBB : I_DTBF)[l * 12 + h]; const float A = expf(INP(dir ? I_ALB : I_ALF)[l * 12 + h]);
                float* mq = MASK + ((size_t)(b * 16 + h) * 4 + 2 * dir) * NKEY; float* mkk = mq + NKEY;
                float la[36], ldt[36];
                RSBAR();
#pragma unroll
                for (int i = 0; i < 36; ++i) { const int p = i * 64 + lane; int n = p; if (dir) { const int bp = 2303 - p; n = bp < SEQ ? CTXL + bp : bp - SEQ; }
                    const int row = n < CTXL ? MLAT + b * CTXL + n : b * SEQ + n - CTXL; la[i] = DT[(size_t)row * 24 + dir * 12 + h]; }
                RSBAR();
#pragma unroll
                for (int i = 0; i < 36; ++i) { const float dt = softplus_hw(la[i] + bias); la[i] = -dt * A; ldt[i] = __builtin_amdgcn_logf(dt); }
                float carry = 0.f;
#pragma unroll
                for (int i = 0; i < 36; ++i) { float inc = la[i];
#pragma unroll
                    for (int o = 1; o < 64; o <<= 1) { const float v = __shfl_up(inc, o); if (lane >= o) inc += v; }
                    const float run = carry + inc; carry += __shfl(inc, 63);
                    const int p = i * 64 + lane; int n = p; if (dir) { const int bp = 2303 - p; n = bp < SEQ ? CTXL + bp : bp - SEQ; }
                    mq[n] = run * LOG2E; mkk[n] = run * LOG2E - ldt[i]; }
            }
            for (long i = gtid; i < (long)NBATCH * 4 * NKEY; i += GT) { const int b = (int)(i / (4 * NKEY)), rem = (int)(i - (long)b * 4 * NKEY), h = rem / NKEY, n = rem - h * NKEY;
                const float lf = log1pf(-exp2f(INP(I_RDF)[l * 4 + h])), lb = log1pf(-exp2f(INP(I_RDB)[l * 4 + h]));
                const float vf = lf * (float)n * LOG2E, vb = lb * (float)(n < CTXL ? CTXL - n : 2560 - n) * LOG2E;
                float* m = MASK + ((size_t)(b * 16 + 12 + h) * 4) * NKEY; m[n] = vf; m[NKEY + n] = vf; m[2 * NKEY + n] = vb; m[3 * NKEY + n] = vb; }
        }
        END_PH();
        if (PH_EN(5) && IN_PH()) for (int rep_ = 0; rep_ < 1 + PH_DUP(5); ++rep_) { if (rep_) __syncthreads(); PH_VARS();
            const int NU = 1024 + (l == 0 ? 128 : 0);
            const int vcu = (G % 8 == 0) ? ((int)blockIdx.x % 8) * (G / 8) + (int)blockIdx.x / 8 : (int)blockIdx.x;
            for (int mrep_ = 0; mrep_ < 1 + MIX_DUP(0); ++mrep_) if (MIX_EN(0)) for (int u = vcu; u < NU; u += G) {
                int b, job, qrow0, ctx_row0, lat_row0, NT, qn0, tq0; bool latq;
                if (u < 1024) { const int r = u >> 8, k = u & 255, qblk = k & 7, kb = k >> 3; b = kb & 7; job = r * 4 + (kb >> 3); qrow0 = b * SEQ + qblk * 256; NT = 36; latq = true; qn0 = CTXL + qblk * 256; tq0 = qblk * 256; }
                else { const int uu = u - 1024; b = uu & 7; job = uu >> 3; qrow0 = MLAT + b * CTXL; NT = 4; latq = false; qn0 = 0; tq0 = 0; }
                ctx_row0 = MLAT + b * CTXL; lat_row0 = b * SEQ;
                if (job >= 6) continue;
                __syncthreads();
                const int tid_u = otid(), lane_u = tid_u & 63, wid = __builtin_amdgcn_readfirstlane(tid_u >> 6), hi = lane_u >> 5, r32 = lane_u & 31; (void)hi; (void)r32; (void)wid;
                    const int h = job, kvh = h / 3;
                    mx::ATTN_BODY(PROJ + (size_t)qrow0 * DINP + C_AQ + h * 128, PROJ + C_AK + kvh * 128, PROJ + C_AV + kvh * 128, DINP, ctx_row0, lat_row0, NT,
                                  ACT + (size_t)qrow0 * DM + h * 128, DM, (char*)lds);
            }
            for (int mrep_ = 0; mrep_ < 1 + MIX_DUP(1); ++mrep_) if (MIX_EN(1)) for (int u = vcu; u < NU; u += G) {
                int b, job, qrow0, ctx_row0, lat_row0, NT, qn0, tq0; bool latq;
                if (u < 1024) { const int r = u >> 8, k = u & 255, qblk = k & 7, kb = k >> 3; b = kb & 7; job = r * 4 + (kb >> 3); qrow0 = b * SEQ + qblk * 256; NT = 36; latq = true; qn0 = CTXL + qblk * 256; tq0 = qblk * 256; }
                else { const int uu = u - 1024; b = uu & 7; job = uu >> 3; qrow0 = MLAT + b * CTXL; NT = 4; latq = false; qn0 = 0; tq0 = 0; }
                ctx_row0 = MLAT + b * CTXL; lat_row0 = b * SEQ;
                if (job < 6 || job >= 10) continue;
                __syncthreads();
                const int tid_u = otid(), lane_u = tid_u & 63, wid = __builtin_amdgcn_readfirstlane(tid_u >> 6), hi = lane_u >> 5, r32 = lane_u & 31; (void)hi; (void)r32; (void)wid;
                    const int h = job - 6; mx::f32x16 o[4];
                    mx::LIN_BODY<1>(PROJ + (size_t)qrow0 * DINP + C_RQ + h * 128, PROJ + C_RK + h * 128, PROJ + C_RV + h * 128, DINP, ctx_row0, lat_row0, NT,
                                    MASK + ((size_t)(b * 16 + 12 + h) * 4) * NKEY, qn0, tq0, latq, o, (char*)lds);
                    float ss[16];
#pragma unroll
                    for (int r = 0; r < 16; ++r) { float s = 0.f;
#pragma unroll
                        for (int d0 = 0; d0 < 4; ++d0) s += o[d0][r] * o[d0][r];
#pragma unroll
                        for (int of = 1; of < 32; of <<= 1) s += __shfl_xor(s, of);
                        ss[r] = rsqrtf(s * (1.f / 128.f) + EPSN); }
                    unsigned short gv[16][4];
                    mx::SBAR_();
#pragma unroll
                    for (int r = 0; r < 16; ++r) { const size_t row = (size_t)qrow0 + wid * 32 + mx::crow(r, hi);
#pragma unroll
                        for (int d0 = 0; d0 < 4; ++d0) gv[r][d0] = __builtin_nontemporal_load(PROJ + row * DINP + C_RG + h * 128 + 32 * d0 + r32); }
                    mx::SBAR_();
#pragma unroll
                    for (int r = 0; r < 16; ++r) { const size_t row = (size_t)qrow0 + wid * 32 + mx::crow(r, hi);
#pragma unroll
                        for (int d0 = 0; d0 < 4; ++d0) ACT[row * DM + 768 + h * 128 + 32 * d0 + r32] = mx::f2bf(o[d0][r] * ss[r] * pg8::silu_f(mx::bf2f(gv[r][d0]))); }
            }
            for (int mrep_ = 0; mrep_ < 1 + MIX_DUP(2); ++mrep_) if (MIX_EN(2)) for (int u = vcu; u < NU; u += G) {
                int b, job, qrow0, ctx_row0, lat_row0, NT, qn0, tq0; bool latq;
                if (u < 1024) { const int r = u >> 8, k = u & 255, qblk = k & 7, kb = k >> 3; b = kb & 7; job = r * 4 + (kb >> 3); qrow0 = b * SEQ + qblk * 256; NT = 36; latq = true; qn0 = CTXL + qblk * 256; tq0 = qblk * 256; }
                else { const int uu = u - 1024; b = uu & 7; job = uu >> 3; qrow0 = MLAT + b * CTXL; NT = 4; latq = false; qn0 = 0; tq0 = 0; }
                ctx_row0 = MLAT + b * CTXL; lat_row0 = b * SEQ;
                if (job < 10) continue;
                __syncthreads();
                const int tid_u = otid(), lane_u = tid_u & 63, wid = __builtin_amdgcn_readfirstlane(tid_u >> 6), hi = lane_u >> 5, r32 = lane_u & 31; (void)hi; (void)r32; (void)wid;
                    const int p = job - 10, g = p / 3; mx::f32x16 o[4];
                    mx::LIN_BODY<2>(CV + (size_t)qrow0 * CVW + 1024 + g * 128, CV + 768 + g * 128, CV + p * 128, CVW, ctx_row0, lat_row0, NT,
                                    MASK + ((size_t)(b * 16 + 2 * p) * 4) * NKEY, qn0, tq0, latq, o, (char*)lds);
                    const float ds0 = INP(I_DSKIP)[l * 12 + 2 * p], ds1 = INP(I_DSKIP)[l * 12 + 2 * p + 1];
                    unsigned short xv[16][4], zv[16][4];
                    mx::SBAR_();
#pragma unroll
                    for (int r = 0; r < 16; ++r) { const size_t row = (size_t)qrow0 + wid * 32 + mx::crow(r, hi);
#pragma unroll
                        for (int d0 = 0; d0 < 4; ++d0) { xv[r][d0] = CV[row * CVW + p * 128 + 32 * d0 + r32]; zv[r][d0] = __builtin_nontemporal_load(PROJ + row * DINP + C_Z + p * 128 + 32 * d0 + r32); } }
                    mx::SBAR_();
#pragma unroll
                    for (int r = 0; r < 16; ++r) { const size_t row = (size_t)qrow0 + wid * 32 + mx::crow(r, hi);
#pragma unroll
                        for (int d0 = 0; d0 < 4; ++d0) ACT[row * DM + 1280 + p * 128 + 32 * d0 + r32] = mx::f2bf((o[d0][r] + (d0 < 2 ? ds0 : ds1) * mx::bf2f(xv[r][d0])) * pg8::silu_f(mx::bf2f(zv[r][d0]))); }
            }
        }
        END_PH();
        if (PH_EN(6) && IN_PH()) for (int rep_ = 0; rep_ < 1 + PH_DUP(6); ++rep_) { if (rep_) __syncthreads(); PH_VARS();
            const float* sg = INP(I_SSDG) + (size_t)l * 768;
            f32x4 gv[3];
#pragma unroll
            for (int j = 0; j < 3; ++j) gv[j] = *(const f32x4*)(sg + j * 256 + lane * 4);
            for (int row0 = gw; row0 < Mcur; row0 += 3 * NGW) {
                u32x2 w[3][3];
                RSBAR();
#pragma unroll
                for (int q = 0; q < 3; ++q) { const int row = row0 + q * NGW;
#pragma unroll
                    for (int j = 0; j < 3; ++j) w[q][j] = (row < Mcur) ? *(const u32x2*)(ACT + (size_t)row * DM + 1280 + j * 256 + lane * 4) : (u32x2){0u, 0u}; }
                RSBAR();
#pragma unroll
                for (int q = 0; q < 3; ++q) { const int row = row0 + q * NGW; f32x4 v[3]; float ss = 0.f;
#pragma unroll
                    for (int j = 0; j < 3; ++j) { v[j] = (f32x4){bflo(w[q][j].x), bfhi(w[q][j].x), bflo(w[q][j].y), bfhi(w[q][j].y)};
                        ss += (v[j].x * v[j].x + v[j].y * v[j].y) + (v[j].z * v[j].z + v[j].w * v[j].w); }
                    const float rstd = rsqrtf(wave_sum(ss) * (1.f / 768.f) + EPSN);
                    if (row < Mcur) {
#pragma unroll
                        for (int j = 0; j < 3; ++j) { const f32x4 y = (v[j] * rstd) * gv[j]; u32x2 o; o.x = pkbf(y.x, y.y); o.y = pkbf(y.z, y.w);
                            *(u32x2*)(ACT + (size_t)row * DM + 1280 + j * 256 + lane * 4) = o; } } }
            }
        }
        END_PH();
        if (PH_EN(7) && IN_PH()) for (int rep_ = 0; rep_ < 1 + PH_DUP(7); ++rep_) { if (rep_) __syncthreads(); PH_VARS();
            pg8::Gemm g{ACT, WOUT_T + (size_t)l * DM * DM, Mcur, DM, DM}; pg8::StaticOrder S; S.init(Mcur, DM, G, (int)blockIdx.x);
            pg8::EpiStore E{MF, DM, nullptr, -1};
            pg8::gemm_phase<pg8::EpiStore, pg8::StaticOrder, true, true>((PG8_LAS unsigned char*)lds, g, S, E);
            if (l == 0) {
                const int nb_ = (576 - 2 * G > 0 && 576 - 2 * G < G) ? 576 - 2 * G : 0;
                if (TAILCUT > 18944 && (int)blockIdx.x >= nb_) CONVERT_ITEMS(18944, (TAILCUT < 24576 ? TAILCUT : 24576), ((int)blockIdx.x - nb_) * 8 + wid, (G - nb_) * 8);
            }
        }
        END_PH();
        if (PH_EN(8) && IN_PH()) for (int rep_ = 0; rep_ < 1 + PH_DUP(8); ++rep_) { if (rep_) __syncthreads(); PH_VARS();
            for (int row = gw; row < Mcur; row += NGW) {
                bf16_t* xb = XB + (size_t)row * DM;
                if (l == 0) { const float* xin = row < MLAT ? INP(I_X) + (size_t)row * DM : INP(I_CTX) + (size_t)(row - MLAT) * DM;
                    row_op<false, true>(xin, nullptr, MF + (size_t)row * DM, mod_vec(MOD, l, row, 2), nullptr, xb,
                                        mod_vec(MOD, l, row, 4), mod_vec(MOD, l, row, 3), ACT + (size_t)row * DM, lane); }
                else row_op<true, true>(nullptr, xb, MF + (size_t)row * DM, mod_vec(MOD, l, row, 2), nullptr, xb,
                                        mod_vec(MOD, l, row, 4), mod_vec(MOD, l, row, 3), ACT + (size_t)row * DM, lane);
            }
        }
        END_PH();
        if (PH_EN(9) && IN_PH()) for (int rep_ = 0; rep_ < 1 + PH_DUP(9); ++rep_) { if (rep_) __syncthreads(); PH_VARS();
            pg8::Gemm g{ACT, WGU_T + (size_t)l * 2 * DFF * DM, Mcur, 2 * DFF, DM}; pg8::StaticOrder S; S.init(Mcur, 2 * DFF, G, (int)blockIdx.x);
            pg8::EpiSwiglu E{PROJ, DFF};
            pg8::gemm_phase<pg8::EpiSwiglu, pg8::StaticOrder, true, true>((PG8_LAS unsigned char*)lds, g, S, E);
        }
        END_PH();
        if (PH_EN(10) && IN_PH()) for (int rep_ = 0; rep_ < 1 + PH_DUP(10); ++rep_) { if (rep_) __syncthreads(); PH_VARS();
            pg8::Gemm g{PROJ, WD_T + (size_t)l * DM * DFF, Mcur, DM, DFF}; pg8::StaticOrder S; S.init(Mcur, DM, G, (int)blockIdx.x);
            pg8::EpiStore E{MF, DM, nullptr, -1};
            pg8::gemm_phase<pg8::EpiStore, pg8::StaticOrder, true, true>((PG8_LAS unsigned char*)lds, g, S, E);
            if (l == 0) {
                const int nb_ = (576 - 2 * G > 0 && 576 - 2 * G < G) ? 576 - 2 * G : 0;
                if (TAILCUT > 24576 && (int)blockIdx.x >= nb_) CONVERT_ITEMS(24576, TAILCUT, ((int)blockIdx.x - nb_) * 8 + wid, (G - nb_) * 8);
            }
        }
        END_PH();
        if (PH_EN(11) && IN_PH()) for (int rep_ = 0; rep_ < 1 + PH_DUP(11); ++rep_) { if (rep_) __syncthreads(); PH_VARS();
            for (int row = gw; row < Mcur; row += NGW) {
                bf16_t* xb = XB + (size_t)row * DM;
                if (l == 0) row_op<true, true>(nullptr, xb, MF + (size_t)row * DM, mod_vec(MOD, l, row, 5), nullptr, xb,
                                               mod_vec(MOD, 1, row, 1), mod_vec(MOD, 1, row, 0), ACT + (size_t)row * DM, lane);
                else row_op<true, false>(nullptr, xb, MF + (size_t)row * DM, mod_vec(MOD, l, row, 5), OUTP + (size_t)row * DM, nullptr,
                                         nullptr, nullptr, nullptr, lane);
            }
        }
        END_PH();
    }
#undef IN_PH
#undef END_PH
}

extern "C" void kernel_launch(void* const* d_in, const int* in_sizes, int n_in, void* d_out, int out_size, void* d_ws, size_t ws_size, hipStream_t stream) {
    static int grid = 0;
    if (grid == 0) {
        if (n_in != N_IN || out_size != MLAT * DM || ws_size < WS_END) { fprintf(stderr, "kernel_launch: unexpected shapes: n_in %d out %d ws %zu (need %zu)\n", n_in, out_size, ws_size, (size_t)WS_END); grid = -1; return; }
        int dev = 0, cus = 0, per_cu = 0;
        if (hipGetDevice(&dev) != hipSuccess || hipDeviceGetAttribute(&cus, hipDeviceAttributeMultiprocessorCount, dev) != hipSuccess) { grid = -1; return; }
        if (hipFuncSetAttribute((const void*)hybrid_fwd, hipFuncAttributeMaxDynamicSharedMemorySize, LDS_BYTES) != hipSuccess) { fprintf(stderr, "kernel_launch: hipFuncSetAttribute failed\n"); grid = -1; return; }
        if (hipOccupancyMaxActiveBlocksPerMultiprocessor(&per_cu, (const void*)hybrid_fwd, 512, LDS_BYTES) != hipSuccess || per_cu < 1) { fprintf(stderr, "kernel_launch: occupancy query gave %d\n", per_cu); per_cu = 1; }
        (void)hipGetLastError();
        grid = cus * 1;
        fprintf(stderr, "kernel_launch: grid %d (cus %d, per_cu %d), ws %zu\n", grid, cus, per_cu, ws_size);
    }
    if (grid < 0) return;
    if (hipMemsetAsync((char*)d_ws + WS_BAR, 0, XCD_BAR_WORDS * 4, stream) != hipSuccess) { fprintf(stderr, "kernel_launch: memset failed\n"); return; }
    KArgs a{};
    for (int i = 0; i < N_IN; ++i) a.in[i] = (const float*)d_in[i];
    a.out = (float*)d_out; a.ws = (unsigned char*)d_ws;
#if MK_PER_PHASE
    for (int ph = 0; ph < NPHASE; ++ph) { a.ph_lo = ph; a.ph_hi = ph + 1; hipLaunchKernelGGL(hybrid_fwd, dim3(grid), dim3(512), LDS_BYTES, stream, a); }
#else
#ifndef MK_PH_HI
#define MK_PH_HI NPHASE
#endif
    a.ph_lo = 0; a.ph_hi = MK_PH_HI;
    void* args[] = {&a};
    hipError_t e = hipLaunchCooperativeKernel((void*)hybrid_fwd, dim3(grid), dim3(512), args, LDS_BYTES, stream);
    if (e != hipSuccess) fprintf(stderr, "kernel_launch: cooperative launch failed: %s (grid %d)\n", hipGetErrorString(e), grid);
#endif
}
```

```cpp
#define TAILCUT 43520
#include <hip/hip_runtime.h>
#include <hip/hip_cooperative_groups.h>
#include <cstdio>
#include <cstdint>
namespace cg = cooperative_groups;
__device__ __forceinline__ int otid() { int t = threadIdx.x; asm volatile("" : "+v"(t)); return t; }
namespace pg8 {
#define PG8_LAS __attribute__((address_space(3)))
typedef unsigned short bf16_t;
typedef short bf16x8 __attribute__((ext_vector_type(8)));
typedef float f32x4 __attribute__((ext_vector_type(4)));
typedef unsigned u32x4 __attribute__((ext_vector_type(4)));
constexpr int BM = 256, BK = 64, HALF = 128, HTB = HALF * BK * 2  , STAGE_BYTES = 8 * HTB, NXCD = 8, WGM = 8;

__host__ __device__ __forceinline__ int lds_byte(int r, int c) { const int st = (r >> 4) * 2 + (c >> 5), rr = r & 15, cc = c & 31, ob = rr * 64 + cc * 2; return st * 1024 + (ob ^ (((ob >> 9) & 1) << 5)); }
__host__ __device__ __forceinline__ void stage_rc(int b, int& R, int& C) { const int st = b / 1024, sb = b % 1024, swz = sb ^ (((sb >> 9) & 1) << 5); R = (st >> 1) * 16 + swz / 64; C = (st & 1) * 32 + (swz % 64) / 2; }
__host__ __device__ __forceinline__ int perm32(int rho) { const int n = rho >> 4, i = rho & 15; return 8 * (i >> 2) + 4 * n + (i & 3); }

struct Unit { int pm, pn; };
struct Gemm { const bf16_t* A; const bf16_t* Bt; int M, N, K; };

struct StaticOrder {
    int nM, nN, nwg, G, c;
    __host__ __device__ void init(int M, int N, int G_, int c_) { nM = M / BM; nN = N / BM; nwg = nM * nN; G = G_; c = c_; }
    __host__ __device__ bool next(int i, Unit& u) const {
        const long L = (long)i * G + c; if (L >= nwg) return false;
        int wgid = (int)L; { const int q = nwg / NXCD, r = nwg % NXCD, xcd = wgid % NXCD, off = wgid / NXCD; wgid = (xcd < r ? xcd * (q + 1) : r * (q + 1) + (xcd - r) * q) + off; }
        const int nig = WGM * nN, gid = wgid / nig, fm = gid * WGM, gsz = (nM - fm) < WGM ? (nM - fm) : WGM;
        u.pm = fm + ((wgid % nig) % gsz); u.pn = (wgid % nig) / gsz; return true;
    }
    __device__ __forceinline__ void a_ready(const Unit&) const {}
    __device__ __forceinline__ void done(const Unit&) const {}
};

__device__ __forceinline__ unsigned cvt_pk_bf16(float lo, float hi) { unsigned r; asm volatile("v_cvt_pk_bf16_f32 %0, %1, %2" : "=v"(r) : "v"(lo), "v"(hi)); return r; }
typedef float f32x2 __attribute__((ext_vector_type(2)));
__device__ __forceinline__ float silu_f(float x) { return x * __builtin_amdgcn_rcpf(1.0f + __builtin_amdgcn_exp2f(-1.4426950408889634f * x)); }
struct EpiStore {
    static constexpr bool PERM = true, AFTER_DRAIN = false;
    bf16_t* O; int ldc; float* dt; int dt_pn;
    __device__ __forceinline__ void operator()(const f32x4 (&acc)[2][2][4][2], const Unit& u, int wr, int wc, int fr, int fq) const {
        const int row0 = u.pm * BM + wr * 64 + fr; const int col0 = u.pn * BM + wc * 32 + 8 * fq;
#pragma unroll
        for (int ai = 0; ai < 2; ++ai)
#pragma unroll
            for (int m = 0; m < 4; ++m) { bf16_t* rowp = O + (size_t)(row0 + ai * HALF + m * 16) * ldc + col0;
#pragma unroll
                for (int bj = 0; bj < 2; ++bj) { const f32x4 v0 = acc[ai][bj][m][0], v1 = acc[ai][bj][m][1];
                    u32x4 w; w.x = cvt_pk_bf16(v0[0], v0[1]); w.y = cvt_pk_bf16(v0[2], v0[3]); w.z = cvt_pk_bf16(v1[0], v1[1]); w.w = cvt_pk_bf16(v1[2], v1[3]);
                    *(u32x4*)(rowp + bj * HALF) = w; } }
        if (dt != nullptr && u.pn == dt_pn && wc == 0 && fq < 3) {
#pragma unroll
            for (int ai = 0; ai < 2; ++ai)
#pragma unroll
                for (int m = 0; m < 4; ++m) { float* d = dt + (size_t)(row0 + ai * HALF + m * 16) * 24 + 8 * fq;
                    *(f32x4*)d = acc[ai][0][m][0]; *(f32x4*)(d + 4) = acc[ai][0][m][1]; }
        }
    }
};
struct EpiSwiglu {
    static constexpr bool PERM = true, AFTER_DRAIN = false;
    bf16_t* O; int ldc;
    __device__ __forceinline__ void operator()(const f32x4 (&acc)[2][2][4][2], const Unit& u, int wr, int wc, int fr, int fq) const {
        const int row0 = u.pm * BM + wr * 64 + fr; const int col0 = u.pn * HALF + wc * 32 + 8 * fq;
#pragma unroll
        for (int ai = 0; ai < 2; ++ai)
#pragma unroll
            for (int m = 0; m < 4; ++m) { bf16_t* rowp = O + (size_t)(row0 + ai * HALF + m * 16) * ldc + col0;
                const f32x4 g0 = acc[ai][0][m][0], g1 = acc[ai][0][m][1], u0 = acc[ai][1][m][0], u1 = acc[ai][1][m][1];
                u32x4 w; w.x = cvt_pk_bf16(silu_f(g0[0]) * u0[0], silu_f(g0[1]) * u0[1]); w.y = cvt_pk_bf16(silu_f(g0[2]) * u0[2], silu_f(g0[3]) * u0[3]);
                w.z = cvt_pk_bf16(silu_f(g1[0]) * u1[0], silu_f(g1[1]) * u1[1]); w.w = cvt_pk_bf16(silu_f(g1[2]) * u1[2], silu_f(g1[3]) * u1[3]);
                *(u32x4*)rowp = w; }
    }
};
struct InprojOrder {
    StaticOrder base; int G, c, skip;
    __device__ void init(int G_, int c_, int skip_) { base.init(16384, 5632, G_, c_); G = G_; c = c_; skip = skip_; }
    __device__ bool next(int i, Unit& u) const {
        if (base.next(i, u)) return true;
        const int j = i * G + c - base.nwg, nextra = skip ? 96 : 176;
        if (j >= nextra) return false;
        const int jj = j >> 3; u.pm = 64 + (j & 7); u.pn = skip ? (jj < 2 ? 3 + jj : (jj < 6 ? 5 + jj : 10 + jj)) : jj; return true;
    }
    __device__ __forceinline__ void a_ready(const Unit&) const {}
    __device__ __forceinline__ void done(const Unit&) const {}
};
template <class Epi, class Sched, bool ALIGN_EPI = false, bool SP2 = false>
__device__ __forceinline__ void gemm_phase(PG8_LAS unsigned char* lds, const Gemm g, const Sched& S, const Epi& E) {
    const int tid = otid(), wid = __builtin_amdgcn_readfirstlane(tid >> 6), lane = tid & 63, wr = wid >> 2, wc = wid & 3, fr = lane & 15, fq = lane >> 4;
    const int K = g.K, nt = K / BK;
    unsigned voffA[2], voffB[2];
#pragma unroll
    for (int i = 0; i < 2; ++i) { int R, C; stage_rc(tid * 16 + i * 8192, R, C); const int Rb = Epi::PERM ? ((R & ~31) + perm32(R & 31)) : R;
        voffA[i] = (unsigned)(R * K + C) * 2u; voffB[i] = (unsigned)(Rb * K + C) * 2u; }
    const size_t kstep = (size_t)(BK * 2);
    const size_t hstep = (size_t)HALF * K * 2;
    const size_t tstep = 2 * hstep;
    const unsigned ldsw = (unsigned)wid * 1024u;
    const int aoff = lds_byte(wr * 64 + fr, fq * 8), boff = lds_byte(wc * 32 + fr, fq * 8);
#define PG8_SA(b, h) (((b) * 2 + (h)) * HTB)
#define PG8_SB(b, h) ((4 + (b) * 2 + (h)) * HTB)
#define PG8_STAGE(bufoff, gbase, voff) do { _Pragma("unroll") for (int _i = 0; _i < 2; ++_i) \
        __builtin_amdgcn_global_load_lds((const unsigned*)((const char*)(gbase) + (voff)[_i]), (PG8_LAS unsigned*)(lds + (bufoff) + ldsw + _i * 8192), 16, 0, 0); } while (0)
#define PG8_LDA(dst, b, h) do { _Pragma("unroll") for (int m = 0; m < 4; ++m) _Pragma("unroll") for (int k = 0; k < 2; ++k) dst[m][k] = *(const PG8_LAS bf16x8*)(lds + PG8_SA(b, h) + aoff + m * 2048 + k * 1024); } while (0)
#define PG8_LDB(dst, b, h) do { _Pragma("unroll") for (int n = 0; n < 2; ++n) _Pragma("unroll") for (int k = 0; k < 2; ++k) dst[n][k] = *(const PG8_LAS bf16x8*)(lds + PG8_SB(b, h) + boff + n * 2048 + k * 1024); } while (0)
#define PG8_MMA(ai, bj, At, Bt) do { __builtin_amdgcn_s_setprio(1); _Pragma("unroll") for (int m = 0; m < 4; ++m) _Pragma("unroll") for (int n = 0; n < 2; ++n) _Pragma("unroll") for (int k = 0; k < 2; ++k) \
        acc[ai][bj][m][n] = __builtin_amdgcn_mfma_f32_16x16x32_bf16(Bt[n][k], At[m][k], acc[ai][bj][m][n], 0, 0, 0); __builtin_amdgcn_s_setprio(0); } while (0)
#define PG8_WAIT_V(n) asm volatile("s_waitcnt vmcnt(" #n ")" ::: "memory")
#define PG8_WAIT_L(n) asm volatile("s_waitcnt lgkmcnt(" #n ")" ::: "memory")
#define PG8_BAR __builtin_amdgcn_s_barrier()
#define PG8_SCHED __builtin_amdgcn_sched_barrier(0)
    Unit cur, nxt; int ui = 0;
    if (!S.next(0, cur)) return;
    f32x4 acc[2][2][4][2];
#pragma unroll
    for (int a = 0; a < 2; ++a)
#pragma unroll
        for (int b = 0; b < 2; ++b)
#pragma unroll
            for (int m = 0; m < 4; ++m)
#pragma unroll
                for (int n = 0; n < 2; ++n) acc[a][b][m][n] = (f32x4){0.f, 0.f, 0.f, 0.f};
    bf16x8 At[4][2], B0[2][2], B1[2][2];
    const char* cA = (const char*)g.A + (size_t)cur.pm * tstep; const char* cB = (const char*)g.Bt + (size_t)cur.pn * tstep;
    S.a_ready(cur);
    if constexpr (SP2) {
        PG8_STAGE(PG8_SB(0, 0), cB, voffB); PG8_STAGE(PG8_SB(0, 1), cB + hstep, voffB); PG8_STAGE(PG8_SA(0, 0), cA, voffA); PG8_STAGE(PG8_SA(0, 1), cA + hstep, voffA);
        if (wr == 1) PG8_BAR;
        PG8_WAIT_V(2); PG8_BAR;
        PG8_STAGE(PG8_SB(1, 0), cB + kstep, voffB); PG8_STAGE(PG8_SA(1, 0), cA + kstep, voffA); PG8_STAGE(PG8_SB(1, 1), cB + hstep + kstep, voffB);
        PG8_WAIT_V(6); PG8_BAR;
    } else {
        PG8_STAGE(PG8_SB(0, 0), cB, voffB); PG8_STAGE(PG8_SA(0, 0), cA, voffA); PG8_STAGE(PG8_SB(0, 1), cB + hstep, voffB); PG8_STAGE(PG8_SA(0, 1), cA + hstep, voffA);
        if (wr == 1) PG8_BAR;
        PG8_WAIT_V(4); PG8_BAR;
        PG8_STAGE(PG8_SB(1, 0), cB + kstep, voffB); PG8_STAGE(PG8_SA(1, 0), cA + kstep, voffA); PG8_STAGE(PG8_SB(1, 1), cB + hstep + kstep, voffB);
        PG8_WAIT_V(6); PG8_BAR;
    }
    for (;;) {
        const bool has_next = S.next(ui + 1, nxt);
        const char* nA = has_next ? (const char*)g.A + (size_t)nxt.pm * tstep : cA; const char* nB = has_next ? (const char*)g.Bt + (size_t)nxt.pn * tstep : cB;
        for (int t = 0; t < nt; t += 2) {
            const bool last = (t == nt - 2);
            const char* a1 = cA + (size_t)(t + 1) * kstep;
            const char* a2 = last ? nA : cA + (size_t)(t + 2) * kstep; const char* b2 = last ? nB : cB + (size_t)(t + 2) * kstep;
            const char* a3 = a2 + kstep; const char* b3 = b2 + kstep;
            if (last && has_next) S.a_ready(nxt);
            if constexpr (SP2) {
            PG8_LDB(B0, 0, 0); PG8_LDB(B1, 0, 1); PG8_SCHED; PG8_LDA(At, 0, 0); PG8_STAGE(PG8_SA(1, 1), a1 + hstep, voffA);
            PG8_WAIT_V(8); PG8_WAIT_L(0); PG8_BAR; PG8_MMA(0, 0, At, B0); PG8_MMA(0, 1, At, B1); PG8_BAR; PG8_SCHED;
            PG8_LDA(At, 0, 1); PG8_STAGE(PG8_SB(0, 0), b2, voffB); PG8_STAGE(PG8_SB(0, 1), b2 + hstep, voffB); PG8_STAGE(PG8_SA(0, 0), a2, voffA);
            PG8_WAIT_V(8); PG8_WAIT_L(0); PG8_BAR; PG8_MMA(1, 0, At, B0); PG8_MMA(1, 1, At, B1); PG8_BAR; PG8_SCHED;
            PG8_LDB(B0, 1, 0); PG8_LDB(B1, 1, 1); PG8_SCHED; PG8_LDA(At, 1, 0); PG8_STAGE(PG8_SA(0, 1), a2 + hstep, voffA);
            PG8_WAIT_V(8); PG8_WAIT_L(0); PG8_BAR; PG8_MMA(0, 0, At, B0); PG8_MMA(0, 1, At, B1); PG8_BAR; PG8_SCHED;
            PG8_LDA(At, 1, 1); PG8_STAGE(PG8_SB(1, 0), b3, voffB); PG8_STAGE(PG8_SB(1, 1), b3 + hstep, voffB); PG8_STAGE(PG8_SA(1, 0), a3, voffA);
            PG8_WAIT_V(8); PG8_WAIT_L(0); PG8_BAR; PG8_MMA(1, 0, At, B0); PG8_MMA(1, 1, At, B1); PG8_BAR; PG8_SCHED;
            } else {
            PG8_LDB(B0, 0, 0); PG8_SCHED; PG8_LDA(At, 0, 0); PG8_STAGE(PG8_SA(1, 1), a1 + hstep, voffA);
            PG8_WAIT_L(8); PG8_BAR; PG8_WAIT_L(0); PG8_MMA(0, 0, At, B0); PG8_BAR; PG8_SCHED;
            PG8_LDB(B1, 0, 1); PG8_STAGE(PG8_SB(0, 0), b2, voffB);
            PG8_BAR; PG8_WAIT_L(0); PG8_MMA(0, 1, At, B1); PG8_BAR;
            PG8_LDA(At, 0, 1); PG8_STAGE(PG8_SA(0, 0), a2, voffA);
            PG8_BAR; PG8_WAIT_L(0); PG8_MMA(1, 0, At, B0); PG8_BAR; PG8_SCHED;
            PG8_STAGE(PG8_SB(0, 1), b2 + hstep, voffB);
            PG8_WAIT_V(6); PG8_BAR; PG8_MMA(1, 1, At, B1); PG8_BAR;
            PG8_LDB(B0, 1, 0); PG8_SCHED; PG8_LDA(At, 1, 0); PG8_STAGE(PG8_SA(0, 1), a2 + hstep, voffA);
            PG8_WAIT_L(8); PG8_BAR; PG8_WAIT_L(0); PG8_MMA(0, 0, At, B0); PG8_BAR; PG8_SCHED;
            PG8_LDB(B1, 1, 1); PG8_STAGE(PG8_SB(1, 0), b3, voffB);
            PG8_BAR; PG8_WAIT_L(0); PG8_MMA(0, 1, At, B1); PG8_BAR;
            PG8_LDA(At, 1, 1); PG8_STAGE(PG8_SA(1, 0), a3, voffA);
            PG8_BAR; PG8_WAIT_L(0); PG8_MMA(1, 0, At, B0); PG8_BAR; PG8_SCHED;
            PG8_STAGE(PG8_SB(1, 1), b3 + hstep, voffB);
            PG8_WAIT_V(6); PG8_BAR; PG8_MMA(1, 1, At, B1); PG8_BAR;
            }
        }
        if constexpr (ALIGN_EPI) { if (wr == 0) PG8_BAR; }
        if constexpr (!Epi::AFTER_DRAIN) { E(acc, cur, wr, wc, fr, fq); S.done(cur); }
        if (!has_next) break;
#pragma unroll
        for (int a = 0; a < 2; ++a)
#pragma unroll
            for (int b = 0; b < 2; ++b)
#pragma unroll
                for (int m = 0; m < 4; ++m)
#pragma unroll
                    for (int n = 0; n < 2; ++n) acc[a][b][m][n] = (f32x4){0.f, 0.f, 0.f, 0.f};
        cur = nxt; cA = nA; cB = nB; ++ui;
        if constexpr (ALIGN_EPI) { if (wr == 1) PG8_BAR; }
    }
    PG8_WAIT_V(0);
    if constexpr (!ALIGN_EPI) { if (wr == 0) PG8_BAR; }
    PG8_BAR;
    if constexpr (Epi::AFTER_DRAIN) { E.fused(acc, cur, wr, wc, fr, fq, lds, wid, lane); S.done(cur); }
#undef PG8_SA
#undef PG8_SB
#undef PG8_STAGE
#undef PG8_LDA
#undef PG8_LDB
#undef PG8_MMA
#undef PG8_WAIT_V
#undef PG8_WAIT_L
#undef PG8_BAR
#undef PG8_SCHED
}
}
namespace mx {
typedef unsigned short bf16;
using bf16x8 = __attribute__((ext_vector_type(8))) short;
using s16x4  = __attribute__((ext_vector_type(4))) short;
using f32x16 = __attribute__((ext_vector_type(16))) float;
using f32x4  = __attribute__((ext_vector_type(4))) float;
using u32x4  = __attribute__((ext_vector_type(4))) unsigned;
constexpr int D = 128, NW = 8, QBLK = 32, KVBLK = 64;
constexpr float SCALE = 0.088388347648318440f;
constexpr float THR = 8.f;
constexpr int SHM_V = KVBLK * D * 2, SHM_K = KVBLK * D * 2;
constexpr int NSTAGE = 3, STAGE_B = SHM_V + SHM_K;
constexpr int OFF_WS = NSTAGE * STAGE_B;
constexpr int OFF_MK = OFF_WS + NW * 1024;
constexpr int NKEYMAX = 2304;
#define KSWZ(row, colB) ((row) * 256 + ((colB) ^ (((row) & 7) << 4)))
#define SBAR() __builtin_amdgcn_sched_barrier(0)
__device__ __forceinline__ int crow(int r, int hi) { return (r & 3) + 8 * (r >> 2) + 4 * hi; }
__device__ __forceinline__ unsigned cvtpk(float lo, float hi) { unsigned r; asm volatile("v_cvt_pk_bf16_f32 %0, %1, %2" : "=v"(r) : "v"(lo), "v"(hi)); return r; }
__device__ __forceinline__ bf16x8 ld8(const bf16* p) { return *reinterpret_cast<const bf16x8*>(p); }
__device__ __forceinline__ float bf2f(bf16 v) { return __uint_as_float((unsigned)v << 16); }
__device__ __forceinline__ bf16 f2bf(float f) { return (bf16)(cvtpk(f, f) & 0xffffu); }

__device__ __forceinline__ void partialSM(f32x16& p0, f32x16& p1, float& m_reg, float& mn, float& alpha) {
  constexpr float C = SCALE * 1.4426950408889634f;
  float pmax = p0[0];
#pragma unroll
  for (int r = 1; r < 16; ++r) pmax = fmaxf(pmax, p0[r]);
#pragma unroll
  for (int r = 0; r < 16; ++r) pmax = fmaxf(pmax, p1[r]);
  { auto rr = __builtin_amdgcn_permlane32_swap(__float_as_uint(pmax), __float_as_uint(pmax), false, false);
    pmax = fmaxf(__uint_as_float(rr[0]), __uint_as_float(rr[1])); }
  if (__builtin_expect(__all(pmax - m_reg <= THR / SCALE), 1)) { mn = m_reg; alpha = 1.f; }
  else { mn = fmaxf(m_reg, pmax); alpha = __builtin_amdgcn_exp2f((m_reg - mn) * C); m_reg = mn; }
  float mnC = -mn * C;
#pragma unroll
  for (int r = 0; r < 16; ++r) p0[r] = fmaf(p0[r], C, mnC);
#pragma unroll
  for (int r = 0; r < 16; ++r) p1[r] = fmaf(p1[r], C, mnC);
#pragma unroll
  for (int r = 0; r < 16; ++r) p0[r] = __builtin_amdgcn_exp2f(p0[r]);
}
#define PK4(P, BASE, OUT) do { unsigned a0 = cvtpk(P[BASE + 0], P[BASE + 1]), a1 = cvtpk(P[BASE + 2], P[BASE + 3]);   \
    unsigned b0 = cvtpk(P[BASE + 4], P[BASE + 5]), b1 = cvtpk(P[BASE + 6], P[BASE + 7]);                              \
    auto r0 = __builtin_amdgcn_permlane32_swap(a0, b0, false, false); auto r1 = __builtin_amdgcn_permlane32_swap(a1, b1, false, false); \
    u32x4 w = {r0[0], r1[0], r0[1], r1[1]}; OUT = *reinterpret_cast<bf16x8*>(&w); } while (0)
__device__ __forceinline__ void finishSM(f32x16& p0, f32x16& p1, float alpha, float& l_reg, bf16x8& pa0, bf16x8& pa1, bf16x8& pa2, bf16x8& pa3) {
#pragma unroll
  for (int r = 0; r < 16; ++r) p1[r] = __builtin_amdgcn_exp2f(p1[r]);
  float ps = 0;
#pragma unroll
  for (int r = 0; r < 16; ++r) ps += p0[r];
#pragma unroll
  for (int r = 0; r < 16; ++r) ps += p1[r];
  { auto rr = __builtin_amdgcn_permlane32_swap(__float_as_uint(ps), __float_as_uint(ps), false, false);
    ps = __uint_as_float(rr[0]) + __uint_as_float(rr[1]); }
  l_reg = l_reg * alpha + ps;
  PK4(p0, 0, pa0); PK4(p0, 8, pa1); PK4(p1, 0, pa2); PK4(p1, 8, pa3);
}
__device__ __forceinline__ void qkt(f32x16& p0, f32x16& p1, const bf16* Ks, const bf16x8* qr, int r32, int hi) {
  p0 = f32x16{}; p1 = f32x16{};
#define LDK(d0_, h_) (*reinterpret_cast<const bf16x8*>((const char*)Ks + KSWZ((h_) * 32 + r32, ((d0_) * 16 + hi * 8) * 2)))
  bf16x8 a0 = LDK(0, 0), a1 = LDK(0, 1), b0 = LDK(1, 0), b1 = LDK(1, 1);
#pragma unroll
  for (int d0 = 0; d0 < 8; d0 += 2) {
    bf16x8 c0, c1, e0, e1;
    if (d0 + 2 < 8) { c0 = LDK(d0 + 2, 0); c1 = LDK(d0 + 2, 1); } SBAR();
    p0 = __builtin_amdgcn_mfma_f32_32x32x16_bf16(a0, qr[d0], p0, 0, 0, 0);
    p1 = __builtin_amdgcn_mfma_f32_32x32x16_bf16(a1, qr[d0], p1, 0, 0, 0); SBAR();
    if (d0 + 3 < 8) { e0 = LDK(d0 + 3, 0); e1 = LDK(d0 + 3, 1); } SBAR();
    p0 = __builtin_amdgcn_mfma_f32_32x32x16_bf16(b0, qr[d0 + 1], p0, 0, 0, 0);
    p1 = __builtin_amdgcn_mfma_f32_32x32x16_bf16(b1, qr[d0 + 1], p1, 0, 0, 0); SBAR();
    if (d0 + 2 < 8) { a0 = c0; a1 = c1; } if (d0 + 3 < 8) { b0 = e0; b1 = e1; }
  }
#undef LDK
}
__device__ __forceinline__ void qkt_plain(f32x16& p0, f32x16& p1, const bf16* Ks, const bf16x8* qr, int r32, int hi) {
  p0 = f32x16{}; p1 = f32x16{};
#pragma unroll
  for (int d0 = 0; d0 < 8; ++d0) { int cb = (d0 * 16 + hi * 8) * 2;
    bf16x8 b0 = *reinterpret_cast<const bf16x8*>((const char*)Ks + KSWZ(r32, cb));
    bf16x8 b1 = *reinterpret_cast<const bf16x8*>((const char*)Ks + KSWZ(32 + r32, cb));
    p0 = __builtin_amdgcn_mfma_f32_32x32x16_bf16(b0, qr[d0], p0, 0, 0, 0);
    p1 = __builtin_amdgcn_mfma_f32_32x32x16_bf16(b1, qr[d0], p1, 0, 0, 0); }
}
__device__ __forceinline__ int v_st(int k, int c) { const int kk = (k & ~0xC) | ((k & 4) << 1) | ((k & 8) >> 1); return ((kk >> 3) * 4 + (c >> 5)) * 512 + ((kk & 7) * 32 + (c & 31)) * 2; }
__device__ __forceinline__ int v_rd_base(int lane) { return ((lane & 3) << 3) | (((lane >> 2) & 3) << 6) | (((lane >> 4) & 1) << 5) | (((lane >> 5) & 1) << 8); }
constexpr int v_rd_off(int d0, int ks, int half) { return d0 * 512 + ks * 4096 + half * 2048; }
template <int OFF> __device__ __forceinline__ s16x4 tr_read(int vb) {
  s16x4 r; asm volatile("ds_read_b64_tr_b16 %0, %1 offset:%2" : "=&v"(r) : "v"(vb), "i"(OFF) : "memory"); return r;
}
template <int D0> __device__ __forceinline__ void pv_one(f32x16& od, int vb, bf16x8 pa0, bf16x8 pa1, bf16x8 pa2, bf16x8 pa3) {
  const s16x4 l0 = tr_read<v_rd_off(D0, 0, 0)>(vb), h0 = tr_read<v_rd_off(D0, 0, 1)>(vb), l1 = tr_read<v_rd_off(D0, 1, 0)>(vb), h1 = tr_read<v_rd_off(D0, 1, 1)>(vb);
  const s16x4 l2 = tr_read<v_rd_off(D0, 2, 0)>(vb), h2 = tr_read<v_rd_off(D0, 2, 1)>(vb), l3 = tr_read<v_rd_off(D0, 3, 0)>(vb), h3 = tr_read<v_rd_off(D0, 3, 1)>(vb);
  asm volatile("s_waitcnt lgkmcnt(0)" ::: "memory"); SBAR();
#define PK(L, H) (bf16x8){L[0], L[1], L[2], L[3], H[0], H[1], H[2], H[3]}
  od = __builtin_amdgcn_mfma_f32_32x32x16_bf16(pa0, PK(l0, h0), od, 0, 0, 0);
  od = __builtin_amdgcn_mfma_f32_32x32x16_bf16(pa1, PK(l1, h1), od, 0, 0, 0);
  od = __builtin_amdgcn_mfma_f32_32x32x16_bf16(pa2, PK(l2, h2), od, 0, 0, 0);
  od = __builtin_amdgcn_mfma_f32_32x32x16_bf16(pa3, PK(l3, h3), od, 0, 0, 0);
#undef PK
}
#ifdef PV_PIPE
#define PV_RD(D0, L0, H0, L1, H1, L2, H2, L3, H3) do { L0 = tr_read<v_rd_off(D0, 0, 0)>(vb); H0 = tr_read<v_rd_off(D0, 0, 1)>(vb); L1 = tr_read<v_rd_off(D0, 1, 0)>(vb); H1 = tr_read<v_rd_off(D0, 1, 1)>(vb); \
    L2 = tr_read<v_rd_off(D0, 2, 0)>(vb); H2 = tr_read<v_rd_off(D0, 2, 1)>(vb); L3 = tr_read<v_rd_off(D0, 3, 0)>(vb); H3 = tr_read<v_rd_off(D0, 3, 1)>(vb); } while (0)
#define PV_MM(OD, L0, H0, L1, H1, L2, H2, L3, H3) do { \
    OD = __builtin_amdgcn_mfma_f32_32x32x16_bf16(pa0, (bf16x8){L0[0], L0[1], L0[2], L0[3], H0[0], H0[1], H0[2], H0[3]}, OD, 0, 0, 0); \
    OD = __builtin_amdgcn_mfma_f32_32x32x16_bf16(pa1, (bf16x8){L1[0], L1[1], L1[2], L1[3], H1[0], H1[1], H1[2], H1[3]}, OD, 0, 0, 0); \
    OD = __builtin_amdgcn_mfma_f32_32x32x16_bf16(pa2, (bf16x8){L2[0], L2[1], L2[2], L2[3], H2[0], H2[1], H2[2], H2[3]}, OD, 0, 0, 0); \
    OD = __builtin_amdgcn_mfma_f32_32x32x16_bf16(pa3, (bf16x8){L3[0], L3[1], L3[2], L3[3], H3[0], H3[1], H3[2], H3[3]}, OD, 0, 0, 0); } while (0)
__device__ __forceinline__ void pv_d0(f32x16* o, int vb, bf16x8 pa0, bf16x8 pa1, bf16x8 pa2, bf16x8 pa3) {
  s16x4 a0, a1, a2, a3, a4, a5, a6, a7, b0, b1, b2, b3, b4, b5, b6, b7;
  PV_RD(0, a0, a1, a2, a3, a4, a5, a6, a7);
  PV_RD(1, b0, b1, b2, b3, b4, b5, b6, b7);
  asm volatile("s_waitcnt lgkmcnt(8)" ::: "memory"); SBAR();
  PV_MM(o[0], a0, a1, a2, a3, a4, a5, a6, a7); SBAR();
  PV_RD(2, a0, a1, a2, a3, a4, a5, a6, a7);
  asm volatile("s_waitcnt lgkmcnt(8)" ::: "memory"); SBAR();
  PV_MM(o[1], b0, b1, b2, b3, b4, b5, b6, b7); SBAR();
  PV_RD(3, b0, b1, b2, b3, b4, b5, b6, b7);
  asm volatile("s_waitcnt lgkmcnt(8)" ::: "memory"); SBAR();
  PV_MM(o[2], a0, a1, a2, a3, a4, a5, a6, a7); SBAR();
  asm volatile("s_waitcnt lgkmcnt(0)" ::: "memory"); SBAR();
  PV_MM(o[3], b0, b1, b2, b3, b4, b5, b6, b7);
}
#undef PV_RD
#undef PV_MM
#else
__device__ __forceinline__ void pv_d0(f32x16* o, int vb, bf16x8 pa0, bf16x8 pa1, bf16x8 pa2, bf16x8 pa3) {
  pv_one<0>(o[0], vb, pa0, pa1, pa2, pa3); pv_one<1>(o[1], vb, pa0, pa1, pa2, pa3); pv_one<2>(o[2], vb, pa0, pa1, pa2, pa3); pv_one<3>(o[3], vb, pa0, pa1, pa2, pa3);
}
#endif
#define MXLAS __attribute__((address_space(3)))
__device__ __forceinline__ void dma_map(int wid, int lane, int ld, int (&koff)[2], int (&voff)[2]) {
#pragma unroll
  for (int i = 0; i < 2; ++i) { const int b = (2 * wid + i) * 1024 + lane * 16;
    { const int row = b >> 8, colB = (b & 255) ^ ((row & 7) << 4); koff[i] = row * ld + (colB >> 1); }
    { const int sub = b >> 9, e = (b & 511) >> 1, kk = (sub >> 2) * 8 + (e >> 5), c = (sub & 3) * 32 + (e & 31);
      const int k = (kk & ~0xC) | ((kk & 4) << 1) | ((kk & 8) >> 1); voff[i] = k * ld + c; } }
}
#define DMA_ISSUE(T_, st_) do { const long rb_ = tile_row((T_), ctx_row0, lat_row0) * (long)ld; const bf16* kb_ = Kh + rb_; const bf16* vp_ = Vh + rb_; \
    MXLAS unsigned char* sb_ = (MXLAS unsigned char*)lds + (st_) * STAGE_B + wid * 2048; \
    _Pragma("unroll") for (int i_ = 0; i_ < 2; ++i_) { \
      __builtin_amdgcn_global_load_lds((const unsigned*)(vp_ + voff[i_]), (MXLAS unsigned*)(sb_ + i_ * 1024), 16, 0, 0); \
      __builtin_amdgcn_global_load_lds((const unsigned*)(kb_ + koff[i_]), (MXLAS unsigned*)(sb_ + SHM_V + i_ * 1024), 16, 0, 0); } } while (0)
#define RING_SYNC(nwait) do { asm volatile("s_waitcnt vmcnt(" #nwait ") lgkmcnt(0)" ::: "memory"); __builtin_amdgcn_s_barrier(); asm volatile("" ::: "memory"); SBAR(); } while (0)
__device__ __forceinline__ long tile_row(int j, int ctx_row0, int lat_row0) { return j < 4 ? (long)ctx_row0 + 64 * j : (long)lat_row0 + 64 * (j - 4); }

template <bool UF, bool UB, bool MK>
__device__ __forceinline__ void mask_pack(const f32x16& p0, const f32x16& p1, const float* mf, const float* mb, float qf, float qb, int dq,
                                          bf16x8& pa0, bf16x8& pa1, bf16x8& pa2, bf16x8& pa3) {
  float t[8];
#pragma unroll
  for (int half = 0; half < 2; ++half) {
#pragma unroll
    for (int gg = 0; gg < 2; ++gg) {
#pragma unroll
      for (int g2 = 0; g2 < 2; ++g2) { const int g = gg * 2 + g2;
        f32x4 kf4 = {0.f, 0.f, 0.f, 0.f}, kb4 = {0.f, 0.f, 0.f, 0.f};
        if (UF) kf4 = *(const f32x4*)(mf + half * 32 + 8 * g);
        if (UB) kb4 = *(const f32x4*)(mb + half * 32 + 8 * g);
#pragma unroll
        for (int i = 0; i < 4; ++i) { const int ko = half * 32 + 8 * g + i; float w = 0.f;
          if (UF) { float e = __builtin_amdgcn_exp2f(qf - kf4[i]); if (MK) e = (ko <= dq) ? e : 0.f; w += e; }
          if (UB) { float e = __builtin_amdgcn_exp2f(qb - kb4[i]); if (MK) e = (ko >= dq) ? e : 0.f; w += e; }
          const float s = half == 0 ? p0[4 * g + i] : p1[4 * g + i];
          t[g2 * 4 + i] = s * w; }
      }
      bf16x8 out; PK4(t, 0, out); SBAR();
      if (half == 0) { if (gg == 0) pa0 = out; else pa1 = out; } else { if (gg == 0) pa2 = out; else pa3 = out; }
    }
  }
}

template <bool UF, bool UB>
__device__ __forceinline__ void mask_pack_fact(const f32x16& p0, const f32x16& p1, const float* bf, const float* bb, float af, float ab,
                                               bf16x8& pa0, bf16x8& pa1, bf16x8& pa2, bf16x8& pa3) {
  float t[8];
#pragma unroll
  for (int half = 0; half < 2; ++half) {
#pragma unroll
    for (int gg = 0; gg < 2; ++gg) {
#pragma unroll
      for (int g2 = 0; g2 < 2; ++g2) { const int g = gg * 2 + g2;
        f32x4 f4 = {0.f, 0.f, 0.f, 0.f}, b4 = {0.f, 0.f, 0.f, 0.f};
        if (UF) f4 = *(const f32x4*)(bf + half * 32 + 8 * g);
        if (UB) b4 = *(const f32x4*)(bb + half * 32 + 8 * g);
#pragma unroll
        for (int i = 0; i < 4; ++i) { const float s = half == 0 ? p0[4 * g + i] : p1[4 * g + i];
          float w;
          if (UF && UB) w = af * f4[i] + ab * b4[i]; else if (UF) w = af * f4[i]; else w = ab * b4[i];
          t[g2 * 4 + i] = s * w; }
      }
      bf16x8 out; PK4(t, 0, out); SBAR();
      if (half == 0) { if (gg == 0) pa0 = out; else pa1 = out; } else { if (gg == 0) pa2 = out; else pa3 = out; }
    }
  }
}

template <int NH>
__device__ __forceinline__ void lin_body(const bf16* __restrict__ Qb, const bf16* __restrict__ Kh, const bf16* __restrict__ Vh, int ld, int ctx_row0, int lat_row0, int NT,
                                         const float* __restrict__ msk, int qn0, int tq0, bool latq, f32x16 (&o)[4], char* lds) {
  const int tid = otid(), wid = __builtin_amdgcn_readfirstlane(tid >> 6), lane = tid & 63, r32 = lane & 31, hi = lane >> 5;
  float* mk = (float*)(lds + OFF_MK);
  bf16x8 qr[8];
#pragma unroll
  for (int d = 0; d < 4; ++d) o[d] = f32x16{};
  const bf16* Qw = Qb + (long)(wid * QBLK + r32) * ld + hi * 8;
#pragma unroll
  for (int d0 = 0; d0 < 8; ++d0) qr[d0] = ld8(Qw + d0 * 16);
  { float tmpm[NH * 9];
#pragma unroll
    for (int it = 0; it < NH * 9; ++it) { const int i = it * 512 + tid, a = i / NKEYMAX, n = i - a * NKEYMAX; tmpm[it] = msk[(size_t)((a >> 1) * 4 + 1 + 2 * (a & 1)) * NKEYMAX + n]; }
#pragma unroll
    for (int it = 0; it < NH * 9; ++it) { const int i = it * 512 + tid; mk[i] = tmpm[it]; } }
  float qf[NH], qb[NH];
#pragma unroll
  for (int hh = 0; hh < NH; ++hh) { const int nq = qn0 + wid * QBLK + r32; qf[hh] = msk[(size_t)(hh * 4 + 0) * NKEYMAX + nq]; qb[hh] = msk[(size_t)(hh * 4 + 2) * NKEYMAX + nq]; }
  const int tw0 = tq0 + wid * QBLK;
  float reff[NH], refb[NH], af[NH], ab[NH];
#pragma unroll
  for (int hh = 0; hh < NH; ++hh) { reff[hh] = __shfl(qf[hh], 0); refb[hh] = __shfl(qb[hh], 31);
    af[hh] = __builtin_amdgcn_exp2f(qf[hh] - reff[hh]); ab[hh] = __builtin_amdgcn_exp2f(qb[hh] - refb[hh]); }
  float* wsc = (float*)(lds + OFF_WS) + wid * 256;
  int koff[2], voff[2]; dma_map(wid, lane, ld, koff, voff);
  const int vb0 = (int)(uintptr_t)lds + v_rd_base(lane);
  DMA_ISSUE(0, 0); DMA_ISSUE(1, 1);
  RING_SYNC(4);
  int st = 0;
  for (int T = 0; T < NT; ++T) {
    if (T + 2 < NT) { const int s2 = st == 0 ? 2 : st - 1; DMA_ISSUE(T + 2, s2); }
    f32x16 p0, p1;
    qkt_plain(p0, p1, (const bf16*)(lds + st * STAGE_B + SHM_V), qr, r32, hi);
    int mode, s0 = 0;
    if (latq && T < 4) mode = 0;
    else { s0 = 64 * (T - (latq ? 4 : 0)); mode = (s0 + 63 < tw0) ? 1 : ((s0 > tw0 + 31) ? 2 : 3); }
    const int dq = tw0 + r32 - s0 - 4 * hi;
    const int vb = vb0 + st * STAGE_B;
#pragma unroll
    for (int hh = 0; hh < NH; ++hh) {
      const float* mf = mk + (hh * 2 + 0) * NKEYMAX + T * 64 + 4 * hi; const float* mb = mk + (hh * 2 + 1) * NKEYMAX + T * 64 + 4 * hi;
      bf16x8 pa0, pa1, pa2, pa3;
      int dqh = dq; asm volatile("" : "+v"(dqh));
#ifdef MODE_GENERAL_ONLY
      mask_pack<true, true, true>(p0, p1, mf, mb, qf[hh], qb[hh], (mode == 0 ? (hh, 1000) : (mode == 1 ? 1000 : (mode == 2 ? -1000 : dq))), pa0, pa1, pa2, pa3);
#else
      if (mode != 3) {
        if (mode != 2) wsc[(hh * 2 + 0) * 64 + lane] = __builtin_amdgcn_exp2f(reff[hh] - mk[(hh * 2 + 0) * NKEYMAX + T * 64 + lane]);
        if (mode != 1) wsc[(hh * 2 + 1) * 64 + lane] = __builtin_amdgcn_exp2f(refb[hh] - mk[(hh * 2 + 1) * NKEYMAX + T * 64 + lane]);
        asm volatile("s_waitcnt lgkmcnt(0)" ::: "memory");
        const float* bfp = wsc + (hh * 2 + 0) * 64 + 4 * hi; const float* bbp = wsc + (hh * 2 + 1) * 64 + 4 * hi;
        if (mode == 0) mask_pack_fact<true, true>(p0, p1, bfp, bbp, af[hh], ab[hh], pa0, pa1, pa2, pa3);
        else if (mode == 1) mask_pack_fact<true, false>(p0, p1, bfp, bbp, af[hh], ab[hh], pa0, pa1, pa2, pa3);
        else mask_pack_fact<false, true>(p0, p1, bfp, bbp, af[hh], ab[hh], pa0, pa1, pa2, pa3);
      }
      else mask_pack<true, true, true>(p0, p1, mf, mb, qf[hh], qb[hh], dqh, pa0, pa1, pa2, pa3);
#endif
      if (NH == 1) pv_d0(o, vb, pa0, pa1, pa2, pa3);
      else if (hh == 0) { pv_one<0>(o[0], vb, pa0, pa1, pa2, pa3); pv_one<1>(o[1], vb, pa0, pa1, pa2, pa3); }
      else { pv_one<2>(o[2], vb, pa0, pa1, pa2, pa3); pv_one<3>(o[3], vb, pa0, pa1, pa2, pa3); }
    }
    if (T + 2 < NT) RING_SYNC(4); else RING_SYNC(0);
    st = st == 2 ? 0 : st + 1;
  }
}
__device__ __forceinline__ void attn_body2(const bf16* __restrict__ Qb, const bf16* __restrict__ Kh, const bf16* __restrict__ Vh, int ld, int ctx_row0, int lat_row0, int NT,
                                           bf16* __restrict__ Ob, int ldo, char* lds) {
  const int tid = otid(), wid = __builtin_amdgcn_readfirstlane(tid >> 6), lane = tid & 63, r32 = lane & 31, hi = lane >> 5;
  float* ws = (float*)(lds + OFF_WS) + wid * 256; float* li_l = ws; float* al_l = ws + 32;
  float m_reg = -1e30f, l_reg = 0; f32x16 o[4] = {}; bf16x8 qr[8];
  const bf16* Qw = Qb + (long)(wid * QBLK + r32) * ld + hi * 8;
#pragma unroll
  for (int d0 = 0; d0 < 8; ++d0) qr[d0] = ld8(Qw + d0 * 16);
  int koff[2], voff[2]; dma_map(wid, lane, ld, koff, voff);
  const int vb0 = (int)(uintptr_t)lds + v_rd_base(lane);
  DMA_ISSUE(0, 0); DMA_ISSUE(1, 1);
  RING_SYNC(4);
  int st = 0;
  for (int T = 0; T < NT; ++T) {
    if (T + 2 < NT) { const int s2 = st == 0 ? 2 : st - 1; DMA_ISSUE(T + 2, s2); }
    f32x16 p0, p1; float mn, alpha; bf16x8 pa0, pa1, pa2, pa3;
    qkt_plain(p0, p1, (const bf16*)(lds + st * STAGE_B + SHM_V), qr, r32, hi);
    partialSM(p0, p1, m_reg, mn, alpha);
    finishSM(p0, p1, alpha, l_reg, pa0, pa1, pa2, pa3);
    if (__any(alpha < 1.f)) { if (hi == 0) al_l[r32] = alpha; asm volatile("s_waitcnt lgkmcnt(0)" ::: "memory");
#pragma unroll
      for (int d = 0; d < 4; ++d)
#pragma unroll
        for (int r = 0; r < 16; ++r) o[d][r] *= al_l[crow(r, hi)]; }
    pv_d0(o, vb0 + st * STAGE_B, pa0, pa1, pa2, pa3);
    if (T + 2 < NT) RING_SYNC(4); else RING_SYNC(0);
    st = st == 2 ? 0 : st + 1;
  }
  if (hi == 0) li_l[r32] = l_reg; asm volatile("s_waitcnt lgkmcnt(0)" ::: "memory");
  float rli[16];
#pragma unroll
  for (int r = 0; r < 16; ++r) rli[r] = __builtin_amdgcn_rcpf(li_l[crow(r, hi)]);
  bf16* Ow = Ob + (long)(wid * QBLK) * ldo;
#pragma unroll
  for (int r = 0; r < 16; ++r) { int orow = crow(r, hi);
#pragma unroll
    for (int d0 = 0; d0 < 4; ++d0) Ow[(long)orow * ldo + d0 * 32 + r32] = f2bf(o[d0][r] * rli[r]); }
}

#define DMA_ISSUE_K(T_, st_) do { const bf16* kb_ = Kh + tile_row((T_), ctx_row0, lat_row0) * (long)ld; \
    MXLAS unsigned char* sb_ = (MXLAS unsigned char*)lds + (st_) * STAGE_B + SHM_V + wid * 2048; \
    _Pragma("unroll") for (int i_ = 0; i_ < 2; ++i_) __builtin_amdgcn_global_load_lds((const unsigned*)(kb_ + koff[i_]), (MXLAS unsigned*)(sb_ + i_ * 1024), 16, 0, 0); } while (0)
#define DMA_ISSUE_V(T_, st_) do { const bf16* vp_ = Vh + tile_row((T_), ctx_row0, lat_row0) * (long)ld; \
    MXLAS unsigned char* sb_ = (MXLAS unsigned char*)lds + (st_) * STAGE_B + wid * 2048; \
    _Pragma("unroll") for (int i_ = 0; i_ < 2; ++i_) __builtin_amdgcn_global_load_lds((const unsigned*)(vp_ + voff[i_]), (MXLAS unsigned*)(sb_ + i_ * 1024), 16, 0, 0); } while (0)
__device__ __forceinline__ void attn_body3(const bf16* __restrict__ Qb, const bf16* __restrict__ Kh, const bf16* __restrict__ Vh, int ld, int ctx_row0, int lat_row0, int NT,
                                           bf16* __restrict__ Ob, int ldo, char* lds) {
  const int tid = otid(), wid = __builtin_amdgcn_readfirstlane(tid >> 6), lane = tid & 63, r32 = lane & 31, hi = lane >> 5;
  float* ws = (float*)(lds + OFF_WS) + wid * 256; float* li_l = ws; float* al_l = ws + 32;
  int koff[2], voff[2]; dma_map(wid, lane, ld, koff, voff);
  DMA_ISSUE_K(0, 0); DMA_ISSUE_K(1, 1); DMA_ISSUE_V(0, 0);
  DMA_ISSUE_K(2, 2); DMA_ISSUE_V(1, 1);
  float m_reg = -1e30f, l_reg = 0; f32x16 o[4] = {}; bf16x8 qr[8];
  const bf16* Qw = Qb + (long)(wid * QBLK + r32) * ld + hi * 8;
#pragma unroll
  for (int d0 = 0; d0 < 8; ++d0) qr[d0] = __builtin_nontemporal_load(reinterpret_cast<const bf16x8*>(Qw + d0 * 16));
  const int vb0 = (int)(uintptr_t)lds + v_rd_base(lane);
#define RESC3(a) do { if (__any((a) < 1.f)) { if (hi == 0) al_l[r32] = (a); asm volatile("s_waitcnt lgkmcnt(0)" ::: "memory"); \
    _Pragma("unroll") for (int d = 0; d < 4; ++d) _Pragma("unroll") for (int r = 0; r < 16; ++r) o[d][r] *= al_l[crow(r, hi)]; } } while (0)
#define HALF3(j_, X0, X1, Y0, Y1, mnX, alX, alY) do { const int jj_ = (j_); \
    if (jj_ + 2 < NT) DMA_ISSUE_K(jj_ + 2, (jj_ + 2) % 3); if (jj_ + 1 < NT) DMA_ISSUE_V(jj_ + 1, (jj_ + 1) % 3); \
    SBAR(); qkt_plain(X0, X1, (const bf16*)(lds + (jj_ % 3) * STAGE_B + SHM_V), qr, r32, hi); \
    finishSM(Y0, Y1, alY, l_reg, pa0, pa1, pa2, pa3); SBAR(); \
    pv_d0(o, vb0 + ((jj_ + 2) % 3) * STAGE_B, pa0, pa1, pa2, pa3); partialSM(X0, X1, m_reg, mnX, alX); \
    if (jj_ + 2 < NT) RING_SYNC(4); else if (jj_ + 1 < NT) RING_SYNC(2); else RING_SYNC(0); \
    RESC3(alX); } while (0)
  f32x16 pA0, pA1, pB0, pB1; float mnA, mnB, alA, alB; bf16x8 pa0, pa1, pa2, pa3;
  RING_SYNC(0);
  qkt_plain(pA0, pA1, (const bf16*)(lds + SHM_V), qr, r32, hi); partialSM(pA0, pA1, m_reg, mnA, alA);
  RING_SYNC(0);
  for (int j = 1; j + 1 < NT; j += 2) {
    HALF3(j, pB0, pB1, pA0, pA1, mnB, alB, alA);
    HALF3(j + 1, pA0, pA1, pB0, pB1, mnA, alA, alB);
  }
  HALF3(NT - 1, pB0, pB1, pA0, pA1, mnB, alB, alA);
  finishSM(pB0, pB1, alB, l_reg, pa0, pa1, pa2, pa3); SBAR();
  pv_d0(o, vb0 + ((NT - 1) % 3) * STAGE_B, pa0, pa1, pa2, pa3);
  asm volatile("s_waitcnt lgkmcnt(0)" ::: "memory"); __builtin_amdgcn_s_barrier(); asm volatile("" ::: "memory");
  if (hi == 0) li_l[r32] = l_reg; asm volatile("s_waitcnt lgkmcnt(0)" ::: "memory");
  float rli[16];
#pragma unroll
  for (int r = 0; r < 16; ++r) rli[r] = __builtin_amdgcn_rcpf(li_l[crow(r, hi)]);
  bf16* Ow = Ob + (long)(wid * QBLK) * ldo;
#pragma unroll
  for (int r = 0; r < 16; ++r) { int orow = crow(r, hi);
#pragma unroll
    for (int d0 = 0; d0 < 4; ++d0) Ow[(long)orow * ldo + d0 * 32 + r32] = f2bf(o[d0][r] * rli[r]); }
#undef HALF3
#undef RESC3
}

__device__ __forceinline__ void mask_fact1(const f32x16& p0, const f32x16& p1, const float* bk, float a, bf16x8& pa0, bf16x8& pa1, bf16x8& pa2, bf16x8& pa3) {
  float t[8];
#pragma unroll
  for (int half = 0; half < 2; ++half) {
#pragma unroll
    for (int gg = 0; gg < 2; ++gg) {
#pragma unroll
      for (int g2 = 0; g2 < 2; ++g2) { const int g = gg * 2 + g2; const f32x4 f4 = *(const f32x4*)(bk + half * 32 + 8 * g);
#pragma unroll
        for (int i = 0; i < 4; ++i) { const float s = half == 0 ? p0[4 * g + i] : p1[4 * g + i]; t[g2 * 4 + i] = s * (a * f4[i]); } }
      bf16x8 out; PK4(t, 0, out);
      if (half == 0) { if (gg == 0) pa0 = out; else pa1 = out; } else { if (gg == 0) pa2 = out; else pa3 = out; }
    }
  }
}
template <int NH>
__device__ __forceinline__ void lin_body3(const bf16* __restrict__ Qb, const bf16* __restrict__ Kh, const bf16* __restrict__ Vh, int ld, int ctx_row0, int lat_row0, int NT,
                                          const float* __restrict__ msk, int qn0, int tq0, bool latq, f32x16 (&o)[4], char* lds) {
  const int tid = otid(), wid = __builtin_amdgcn_readfirstlane(tid >> 6), lane = tid & 63, r32 = lane & 31, hi = lane >> 5;
  float* mk = (float*)(lds + OFF_MK);
  int koff[2], voff[2]; dma_map(wid, lane, ld, koff, voff);
  DMA_ISSUE_K(0, 0); DMA_ISSUE_K(1, 1); DMA_ISSUE_V(0, 0);
  DMA_ISSUE_K(2, 2); DMA_ISSUE_V(1, 1);
  bf16x8 qr[8];
#pragma unroll
  for (int d = 0; d < 4; ++d) o[d] = f32x16{};
  const bf16* Qw = Qb + (long)(wid * QBLK + r32) * ld + hi * 8;
#pragma unroll
  for (int d0 = 0; d0 < 8; ++d0) qr[d0] = __builtin_nontemporal_load(reinterpret_cast<const bf16x8*>(Qw + d0 * 16));
  { float tmpm[NH * 9];
#pragma unroll
    for (int it = 0; it < NH * 9; ++it) { const int i = it * 512 + tid, a = i / NKEYMAX, n = i - a * NKEYMAX; tmpm[it] = msk[(size_t)((a >> 1) * 4 + 1 + 2 * (a & 1)) * NKEYMAX + n]; }
#pragma unroll
    for (int it = 0; it < NH * 9; ++it) { const int i = it * 512 + tid; mk[i] = tmpm[it]; } }
  float qf[NH], qb[NH];
#pragma unroll
  for (int hh = 0; hh < NH; ++hh) { const int nq = qn0 + wid * QBLK + r32; qf[hh] = msk[(size_t)(hh * 4 + 0) * NKEYMAX + nq]; qb[hh] = msk[(size_t)(hh * 4 + 2) * NKEYMAX + nq]; }
  const int tw0 = tq0 + wid * QBLK;
  float reff[NH], refb[NH], af[NH], ab[NH];
#pragma unroll
  for (int hh = 0; hh < NH; ++hh) { reff[hh] = __shfl(qf[hh], 0); refb[hh] = __shfl(qb[hh], 31);
    af[hh] = __builtin_amdgcn_exp2f(qf[hh] - reff[hh]); ab[hh] = __builtin_amdgcn_exp2f(qb[hh] - refb[hh]); }
  float* wsc = (float*)(lds + OFF_WS) + wid * 256;
  const int vb0 = (int)(uintptr_t)lds + v_rd_base(lane);
#define LMASK(T_, hh_, Y0, Y1, QKT_) do { const int Tm_ = (T_); int mode_, s0_ = 0; \
    if (latq && Tm_ < 4) mode_ = 0; else { s0_ = 64 * (Tm_ - (latq ? 4 : 0)); mode_ = (s0_ + 63 < tw0) ? 1 : ((s0_ > tw0 + 31) ? 2 : 3); } \
    if (mode_ == 1 || mode_ == 2) { const int dsel_ = mode_ - 1; \
      wsc[(hh_) * 64 + lane] = __builtin_amdgcn_exp2f((dsel_ ? refb[hh_] : reff[hh_]) - mk[((hh_) * 2 + dsel_) * NKEYMAX + Tm_ * 64 + lane]); \
      asm volatile("s_waitcnt lgkmcnt(0)" ::: "memory"); SBAR(); \
      QKT_; mask_fact1(Y0, Y1, wsc + (hh_) * 64 + 4 * hi, dsel_ ? ab[hh_] : af[hh_], pa0, pa1, pa2, pa3); SBAR(); } \
    else if (mode_ == 0) { \
      wsc[(hh_) * 64 + lane] = __builtin_amdgcn_exp2f(reff[hh_] - mk[((hh_) * 2 + 0) * NKEYMAX + Tm_ * 64 + lane]); \
      wsc[128 + (hh_) * 64 + lane] = __builtin_amdgcn_exp2f(refb[hh_] - mk[((hh_) * 2 + 1) * NKEYMAX + Tm_ * 64 + lane]); \
      asm volatile("s_waitcnt lgkmcnt(0)" ::: "memory"); \
      QKT_; mask_pack_fact<true, true>(Y0, Y1, wsc + (hh_) * 64 + 4 * hi, wsc + 128 + (hh_) * 64 + 4 * hi, af[hh_], ab[hh_], pa0, pa1, pa2, pa3); } \
    else { int dqh_ = tw0 + r32 - s0_ - 4 * hi; asm volatile("" : "+v"(dqh_)); \
      QKT_; mask_pack<true, true, true>(Y0, Y1, mk + ((hh_) * 2 + 0) * NKEYMAX + Tm_ * 64 + 4 * hi, mk + ((hh_) * 2 + 1) * NKEYMAX + Tm_ * 64 + 4 * hi, qf[hh_], qb[hh_], dqh_, pa0, pa1, pa2, pa3); } } while (0)
#define LPV(T_, Y0, Y1, QKT_) do { const int vb_ = vb0 + ((T_) % 3) * STAGE_B; \
    LMASK(T_, 0, Y0, Y1, QKT_); \
    if (NH == 1) pv_d0(o, vb_, pa0, pa1, pa2, pa3); \
    else { pv_one<0>(o[0], vb_, pa0, pa1, pa2, pa3); pv_one<1>(o[1], vb_, pa0, pa1, pa2, pa3); \
      LMASK(T_, NH - 1, Y0, Y1, (void)0); \
      pv_one<2>(o[2], vb_, pa0, pa1, pa2, pa3); pv_one<3>(o[3], vb_, pa0, pa1, pa2, pa3); } } while (0)
#define HALFL(j_, X0, X1, Y0, Y1) do { const int jj_ = (j_); \
    if (jj_ + 2 < NT) DMA_ISSUE_K(jj_ + 2, (jj_ + 2) % 3); if (jj_ + 1 < NT) DMA_ISSUE_V(jj_ + 1, (jj_ + 1) % 3); \
    LPV(jj_ - 1, Y0, Y1, qkt_plain(X0, X1, (const bf16*)(lds + (jj_ % 3) * STAGE_B + SHM_V), qr, r32, hi)); \
    if (jj_ + 2 < NT) RING_SYNC(4); else if (jj_ + 1 < NT) RING_SYNC(2); else RING_SYNC(0); } while (0)
  f32x16 pA0, pA1, pB0, pB1; bf16x8 pa0, pa1, pa2, pa3;
  RING_SYNC(0);
  qkt_plain(pA0, pA1, (const bf16*)(lds + SHM_V), qr, r32, hi);
  RING_SYNC(0);
  for (int j = 1; j + 1 < NT; j += 2) {
    HALFL(j, pB0, pB1, pA0, pA1);
    HALFL(j + 1, pA0, pA1, pB0, pB1);
  }
  HALFL(NT - 1, pB0, pB1, pA0, pA1);
  LPV(NT - 1, pB0, pB1, (void)0);
  asm volatile("s_waitcnt lgkmcnt(0)" ::: "memory"); __builtin_amdgcn_s_barrier(); asm volatile("" ::: "memory");
#undef HALFL
#undef LPV
#undef LMASK
}
__device__ __forceinline__ void SBAR_() { __builtin_amdgcn_sched_barrier(0); }
#undef PK4
}
#define LAS __attribute__((address_space(3)))
typedef unsigned short bf16_t;
typedef float f32x4 __attribute__((ext_vector_type(4)));
typedef unsigned u32x4 __attribute__((ext_vector_type(4)));
typedef unsigned u32x2 __attribute__((ext_vector_type(2)));
constexpr int DM = 2048, NBATCH = 8, SEQ = 2048, CTXL = 256;
constexpr int MLAT = NBATCH * SEQ, MCTX = NBATCH * CTXL, MTOT = MLAT + MCTX;
constexpr int DIN = 5400, DINP = 5632, DFF = 5632;
constexpr int C_AQ = 0, C_AK = 768, C_AV = 1024, C_RQ = 1280, C_RK = 1792, C_RV = 2304, C_RG = 2816, C_Z = 3328, C_XBC = 4096, C_DT = 5376;
constexpr int CVW = 1280, NKEY = 2304;
constexpr float EPSN = 1e-6f, LOG2E = 1.4426950408889634f;
constexpr size_t MiB = (size_t)1 << 20;
constexpr size_t WS_BAR = (size_t)1 << 20;
constexpr size_t WS_ROPE = 0, WS_MOD = 65536, WS_MODP = 2 * MiB, WS_WIN = 16 * MiB, WS_WOUT = 60 * MiB, WS_WGU = 76 * MiB, WS_WD = 164 * MiB,
                 WS_ACT = 208 * MiB, WS_PROJ = 280 * MiB, WS_CV = 478 * MiB, WS_MF = 523 * MiB, WS_XC = 595 * MiB, WS_MASK = 611 * MiB, WS_DT = 616 * MiB, WS_XB = 618 * MiB, WS_END = 690 * MiB;
constexpr int LDS_BYTES = 147456;
enum { I_X = 0, I_C, I_CTX, I_CCTX, I_WMOD, I_BMOD, I_PREMIX, I_POSTMIX, I_PREFFN, I_POSTFFN, I_WIN, I_QG, I_KG, I_RDF, I_RDB, I_CONVW, I_CONVB, I_DTBF, I_DTBB,
       I_ALF, I_ALB, I_DSKIP, I_SSDG, I_WOUT, I_WGATE, I_WUP, I_WDOWN, N_IN };
struct KArgs { const float* in[N_IN]; float* out; unsigned char* ws; int ph_lo, ph_hi; };

__device__ __forceinline__ float wave_sum(float v) {
#pragma unroll
    for (int o = 1; o < 64; o <<= 1) v += __shfl_xor(v, o);
    return v; }
__device__ __forceinline__ float bflo(unsigned w) { return __uint_as_float(w << 16); }
__device__ __forceinline__ float bfhi(unsigned w) { return __uint_as_float(w & 0xffff0000u); }
__device__ __forceinline__ unsigned pkbf(float lo, float hi) { return pg8::cvt_pk_bf16(lo, hi); }
__device__ __forceinline__ float silu_acc(float x) { return x / (1.0f + expf(-x)); }
__device__ __forceinline__ float softplus_f(float x) { return x > 20.f ? x : log1pf(expf(x)); }
__device__ __forceinline__ float softplus_hw(float x) {
    const float u = __builtin_amdgcn_exp2f(-fabsf(x) * 1.4426950408889634f);
    const float small = u * (1.0f + u * (-0.5f + u * (0.33333334f - 0.25f * u)));
    const float big = __builtin_amdgcn_logf(1.0f + u) * 0.6931471805599453f;
    return fmaxf(x, 0.f) + (u < 0.03125f ? small : big);
}

#define RSBAR() __builtin_amdgcn_sched_barrier(0)
__device__ __forceinline__ void transpose_item(const float* __restrict__ W, int K, int N, int nblk, bf16_t* __restrict__ WT, int mode, float* scr, int item, int lane) {
    const int kb = item / nblk, nb = item - kb * nblk, k0 = 64 * kb, n0 = 32 * nb, n = n0 + (lane & 31);
    float tv[32];
    RSBAR();
#pragma unroll
    for (int i = 0; i < 32; ++i) { const int kk = 2 * i + (lane >> 5); tv[i] = (n < N) ? __builtin_nontemporal_load(W + (size_t)(k0 + kk) * N + n) : 0.f; }
    RSBAR();
#pragma unroll
    for (int i = 0; i < 32; ++i) { const int kk = 2 * i + (lane >> 5); scr[kk * 33 + (lane & 31)] = tv[i]; }
    asm volatile("s_waitcnt lgkmcnt(0)" ::: "memory");
    const int c = lane & 7;
    const int drow0 = (mode == 0) ? n0 : (256 * (n0 >> 7) + (n0 & 127) + (mode == 2 ? 128 : 0));
#pragma unroll
    for (int j = 0; j < 4; ++j) { const int nn = (lane >> 3) + 8 * j; const float* s = scr + (8 * c) * 33 + nn;
        u32x4 o; o.x = pkbf(s[0 * 33], s[1 * 33]); o.y = pkbf(s[2 * 33], s[3 * 33]); o.z = pkbf(s[4 * 33], s[5 * 33]); o.w = pkbf(s[6 * 33], s[7 * 33]);
        *(u32x4*)(WT + (size_t)(drow0 + nn) * K + k0 + 8 * c) = o; }
    asm volatile("s_waitcnt lgkmcnt(0)" ::: "memory");
}

template <bool XIN16, bool XOUT16>
__device__ __forceinline__ void row_op(const float* __restrict__ xin, const bf16_t* xin16, const bf16_t* __restrict__ add, const float* __restrict__ gate,
                                       float* __restrict__ xout, bf16_t* xout16,
                                       const float* __restrict__ sc, const float* __restrict__ sh, bf16_t* __restrict__ hout, int lane) {
    f32x4 v[8]; u32x2 xw[8];
    if (add != nullptr) {
        u32x2 aw[8]; f32x4 g[8];
        RSBAR();
#pragma unroll
        for (int j = 0; j < 8; ++j) { if (XIN16) xw[j] = __builtin_nontemporal_load((const u32x2*)(xin16 + j * 256 + lane * 4)); else v[j] = __builtin_nontemporal_load((const f32x4*)(xin + j * 256 + lane * 4)); aw[j] = __builtin_nontemporal_load((const u32x2*)(add + j * 256 + lane * 4)); }
#pragma unroll
        for (int j = 0; j < 8; ++j) g[j] = *(const f32x4*)(gate + j * 256 + lane * 4);
        RSBAR();
        if (XIN16) {
#pragma unroll
            for (int j = 0; j < 8; ++j) v[j] = (f32x4){bflo(xw[j].x), bfhi(xw[j].x), bflo(xw[j].y), bfhi(xw[j].y)};
        }
        f32x4 a[8]; float ss = 0.f;
#pragma unroll
        for (int j = 0; j < 8; ++j) { a[j] = (f32x4){bflo(aw[j].x), bfhi(aw[j].x), bflo(aw[j].y), bfhi(aw[j].y)};
            ss += (a[j].x * a[j].x + a[j].y * a[j].y) + (a[j].z * a[j].z + a[j].w * a[j].w); }
        const float rstd = rsqrtf(wave_sum(ss) * (1.f / DM) + EPSN);
#pragma unroll
        for (int j = 0; j < 8; ++j) v[j] = v[j] + g[j] * (a[j] * rstd);
    } else {
        RSBAR();
#pragma unroll
        for (int j = 0; j < 8; ++j) { if (XIN16) xw[j] = __builtin_nontemporal_load((const u32x2*)(xin16 + j * 256 + lane * 4)); else v[j] = __builtin_nontemporal_load((const f32x4*)(xin + j * 256 + lane * 4)); }
        RSBAR();
        if (XIN16) {
#pragma unroll
            for (int j = 0; j < 8; ++j) v[j] = (f32x4){bflo(xw[j].x), bfhi(xw[j].x), bflo(xw[j].y), bfhi(xw[j].y)};
        }
    }
    if (XOUT16) {
#pragma unroll
        for (int j = 0; j < 8; ++j) { u32x2 w; w.x = pkbf(v[j].x, v[j].y); w.y = pkbf(v[j].z, v[j].w); xw[j] = w; }
    }
    if (hout != nullptr) {
        f32x4 s[8], h[8];
        RSBAR();
#pragma unroll
        for (int j = 0; j < 8; ++j) { s[j] = *(const f32x4*)(sc + j * 256 + lane * 4); h[j] = *(const f32x4*)(sh + j * 256 + lane * 4); }
        RSBAR();
        if (XOUT16) {
#pragma unroll
            for (int j = 0; j < 8; ++j) __builtin_nontemporal_store(xw[j], (u32x2*)(xout16 + j * 256 + lane * 4));
        } else if (xout != nullptr) {
#pragma unroll
            for (int j = 0; j < 8; ++j) __builtin_nontemporal_store(v[j], (f32x4*)(xout + j * 256 + lane * 4));
        }
        float ss = 0.f;
#pragma unroll
        for (int j = 0; j < 8; ++j) ss += (v[j].x * v[j].x + v[j].y * v[j].y) + (v[j].z * v[j].z + v[j].w * v[j].w);
        const float rstd = rsqrtf(wave_sum(ss) * (1.f / DM) + EPSN);
#pragma unroll
        for (int j = 0; j < 8; ++j) { const f32x4 y = (v[j] * rstd) * s[j] + h[j]; u32x2 w; w.x = pkbf(y.x, y.y); w.y = pkbf(y.z, y.w); *(u32x2*)(hout + j * 256 + lane * 4) = w; }
    } else if (XOUT16) {
#pragma unroll
        for (int j = 0; j < 8; ++j) __builtin_nontemporal_store(xw[j], (u32x2*)(xout16 + j * 256 + lane * 4));
    } else if (xout != nullptr) {
#pragma unroll
        for (int j = 0; j < 8; ++j) __builtin_nontemporal_store(v[j], (f32x4*)(xout + j * 256 + lane * 4));
    }
}
__device__ __forceinline__ const float* mod_vec(const float* MOD, int l, int row, int chunk) { const int r = row < MLAT ? row / SEQ : 8; return MOD + ((size_t)(l * 9 + r) * 6 + chunk) * DM; }

__device__ __forceinline__ unsigned rope_pair(unsigned w, float m0, float m1, float cs, float sn) {
    const float x1 = bflo(w) * m0, x2 = bfhi(w) * m1; return pkbf(x1 * cs - x2 * sn, x1 * sn + x2 * cs); }
template <int NR>
__device__ __forceinline__ void prep_rows(bf16_t* __restrict__ PROJ, const int (&rows)[NR], const float* __restrict__ ROPE, const float* __restrict__ qg, const float* __restrict__ kg, int lane) {
    float cs[NR], sn[NR]; unsigned* p[NR]; unsigned w[NR][16];
    const float qg0 = qg[2 * lane], qg1 = qg[2 * lane + 1], kg0 = kg[2 * lane], kg1 = kg[2 * lane + 1];
#pragma unroll
    for (int q = 0; q < NR; ++q) { const int row = rows[q]; cs[q] = 1.f; sn[q] = 0.f; p[q] = (unsigned*)(PROJ + (size_t)row * DINP);
        if (row < MLAT) { const int t = row & (SEQ - 1), pos = lane < 32 ? (t >> 6) : (t & 63), f = lane & 31; cs[q] = ROPE[(pos * 32 + f) * 2]; sn[q] = ROPE[(pos * 32 + f) * 2 + 1]; }
#pragma unroll
        for (int h = 0; h < 8; ++h) w[q][h] = p[q][h * 64 + lane];
#pragma unroll
        for (int h = 0; h < 4; ++h) { w[q][8 + h] = p[q][C_RQ / 2 + h * 64 + lane]; w[q][12 + h] = p[q][C_RK / 2 + h * 64 + lane]; } }
#pragma unroll
    for (int q = 0; q < NR; ++q) {
        float ss[8];
#pragma unroll
        for (int h = 0; h < 8; ++h) { const float x1 = bflo(w[q][h]), x2 = bfhi(w[q][h]); ss[h] = x1 * x1 + x2 * x2; }
#pragma unroll
        for (int o = 1; o < 64; o <<= 1) {
#pragma unroll
            for (int h = 0; h < 8; ++h) ss[h] += __shfl_xor(ss[h], o); }
#pragma unroll
        for (int h = 0; h < 8; ++h) { const float rstd = rsqrtf(ss[h] * (1.f / 128.f) + EPSN); w[q][h] = rope_pair(w[q][h], rstd * (h < 6 ? qg0 : kg0), rstd * (h < 6 ? qg1 : kg1), cs[q], sn[q]); }
#pragma unroll
        for (int h = 0; h < 4; ++h) { w[q][8 + h] = rope_pair(w[q][8 + h], 1.f, 1.f, cs[q], sn[q]); w[q][12 + h] = rope_pair(w[q][12 + h], 0.08838834764831845f, 0.08838834764831845f, cs[q], sn[q]); }
#pragma unroll
        for (int h = 0; h < 8; ++h) p[q][h * 64 + lane] = w[q][h];
#pragma unroll
        for (int h = 0; h < 4; ++h) { p[q][C_RQ / 2 + h * 64 + lane] = w[q][8 + h]; p[q][C_RK / 2 + h * 64 + lane] = w[q][12 + h]; } }
}
__device__ __forceinline__ unsigned ld_u(const bf16_t* PROJ, int row, int S0, int S1, int ch) { return (row >= S0 && row < S1) ? __builtin_nontemporal_load((const unsigned*)(PROJ + (size_t)row * DINP + C_XBC + ch)) : 0u; }
#define XB_TMO      128
#define XB_XCNT(j)  (256  + 64 * (j))
#define XB_XSUB(j)  (1280 + 64 * (j))
#define XB_XGEN(j)  (2304 + 64 * (j))
#define XB_TOP      3328
#define XB_TOPGEN   3392
#define XCD_BAR_WORDS 3456
#define XB_SPIN_CAP (1u << 18)

__device__ __forceinline__ unsigned xb_ld(unsigned* p)              { return __hip_atomic_load(p, __ATOMIC_RELAXED, __HIP_MEMORY_SCOPE_AGENT); }
__device__ __forceinline__ unsigned xb_add(unsigned* p, unsigned v) { return __hip_atomic_fetch_add(p, v, __ATOMIC_RELAXED, __HIP_MEMORY_SCOPE_AGENT); }
__device__ __forceinline__ unsigned xb_xcc_id() { return (unsigned)__builtin_amdgcn_s_getreg((3 << 11) | 20) & 0xFu; }
#define XB_SPIN(cond, bar) do { unsigned _sp = 0; while (cond) { __builtin_amdgcn_s_sleep(1); \
    if ((++_sp & 255u) == 0u) { if (xb_ld(&(bar)[XB_TMO])) break; if (_sp > XB_SPIN_CAP) { atomicAdd(&(bar)[XB_TMO], 1u); break; } } } } while (0)

struct XcdBarrier {
    unsigned* bar; unsigned x;
    volatile LAS unsigned* st;
};

__device__ __forceinline__ XcdBarrier xcd_barrier_post(unsigned* bar, volatile LAS unsigned* st) {
    XcdBarrier b; b.bar = bar; b.x = xb_xcc_id(); b.st = st;
    if (threadIdx.x == 0) (void)xb_add(&bar[XB_XCNT(b.x)], 1u);
    return b;
}
__device__ __forceinline__ void xcd_barrier_complete(unsigned* bar, unsigned x, unsigned& nloc, unsigned& nx) {
    const unsigned G = gridDim.x * gridDim.y * gridDim.z;
    unsigned sum, cnt, mine, sp = 0u;
    for (;;) {
        sum = 0u; cnt = 0u; mine = 0u;
#pragma unroll
        for (unsigned j = 0; j < 16; ++j) { const unsigned c = xb_ld(&bar[XB_XCNT(j)]); sum += c; cnt += (c > 0u) ? 1u : 0u; mine = (j == x) ? c : mine; }
        if (sum == G) break;
        __builtin_amdgcn_s_sleep(1);
        if ((++sp & 255u) == 0u) { if (xb_ld(&bar[XB_TMO])) break; if (sp > XB_SPIN_CAP) { atomicAdd(&bar[XB_TMO], 1u); break; } }
    }
    nloc = mine > 0u ? mine : 1u; nx = cnt > 0u ? cnt : 1u;
}

__device__ __forceinline__ void xcd_barrier(const XcdBarrier& b) {
    asm volatile("s_waitcnt vmcnt(0)" ::: "memory");
    __syncthreads();
    if (threadIdx.x == 0) {
        unsigned* bar = b.bar;
        __builtin_amdgcn_s_waitcnt(0);
        unsigned nloc = b.st[0], nx = b.st[1];
        if (nloc == 0u) { xcd_barrier_complete(bar, b.x, nloc, nx); b.st[0] = nloc; b.st[1] = nx; }
        const unsigned old = xb_add(&bar[XB_XSUB(b.x)], 1u);
        const unsigned gen = old / nloc;
        if (old + 1u == (gen + 1u) * nloc) {
            __builtin_amdgcn_fence(__ATOMIC_RELEASE, "agent");
            asm volatile("s_waitcnt vmcnt(0)" ::: "memory");
            const unsigned og = xb_add(&bar[XB_TOP], 1u);
            const unsigned tg = og / nx;
            if (og + 1u == (tg + 1u) * nx) xb_add(&bar[XB_TOPGEN], 1u);
            else XB_SPIN(xb_ld(&bar[XB_TOPGEN]) == tg, bar);
            __builtin_amdgcn_fence(__ATOMIC_ACQUIRE, "agent");
            xb_add(&bar[XB_XGEN(b.x)], 1u);
            asm volatile("s_waitcnt vmcnt(0)" ::: "memory");
        } else {
            XB_SPIN(xb_ld(&bar[XB_XGEN(b.x)]) == gen, bar);
            __builtin_amdgcn_fence(__ATOMIC_ACQUIRE, "agent");
            asm volatile("s_waitcnt vmcnt(0)" ::: "memory");
        }
    }
    __syncthreads();
}

#ifndef TAILCUT
#define TAILCUT 5632
#endif
#ifndef MK_PER_PHASE
#define MK_PER_PHASE 0
#endif
constexpr int NPHASE = 3 + 2 * 9;
__global__ void __launch_bounds__(512, 2) hybrid_fwd(KArgs a) {
    extern __shared__ __attribute__((aligned(16))) unsigned char lds[];
    cg::grid_group grid = cg::this_grid();
    volatile LAS unsigned* bst = (volatile LAS unsigned*)((LAS unsigned char*)lds + LDS_BYTES - 64);
    if (threadIdx.x < 2) bst[threadIdx.x] = 0u;
    __syncthreads();
    XcdBarrier xbar = xcd_barrier_post((unsigned*)(a.ws + WS_BAR), bst);
    const int G = gridDim.x, NGW = G * 8; const long GT = (long)G * 512;
#define PH_VARS() const int tid = otid(), lane = tid & 63, wid = __builtin_amdgcn_readfirstlane(tid >> 6), gw = blockIdx.x * 8 + wid; const long gtid = (long)blockIdx.x * 512 + tid; (void)lane; (void)gw; (void)gtid; \
    int zq = 0; asm volatile("" : "+s"(zq)); unsigned char* ws = (unsigned char*)(__attribute__((address_space(1))) unsigned char*)a.ws + zq; \
    float* ROPE = (float*)(ws + WS_ROPE); float* MOD = (float*)(ws + WS_MOD); float* MODP = (float*)(ws + WS_MODP); \
    bf16_t* WIN_T = (bf16_t*)(ws + WS_WIN); bf16_t* WOUT_T = (bf16_t*)(ws + WS_WOUT); bf16_t* WGU_T = (bf16_t*)(ws + WS_WGU); bf16_t* WD_T = (bf16_t*)(ws + WS_WD); \
    bf16_t* ACT = (bf16_t*)(ws + WS_ACT); bf16_t* PROJ = (bf16_t*)(ws + WS_PROJ); bf16_t* CV = (bf16_t*)(ws + WS_CV); bf16_t* MF = (bf16_t*)(ws + WS_MF); \
    float* XC = (float*)(ws + WS_XC); float* MASK = (float*)(ws + WS_MASK); float* DT = (float*)(ws + WS_DT); bf16_t* XB = (bf16_t*)(ws + WS_XB); (void)XB; float* OUTP = (float*)((__attribute__((address_space(1))) float*)a.out + zq); \
    (void)ROPE; (void)MOD; (void)MODP; (void)WIN_T; (void)WOUT_T; (void)WGU_T; (void)WD_T; (void)ACT; (void)PROJ; (void)CV; (void)MF; (void)XC; (void)MASK; (void)DT; (void)OUTP;
#define INP(i) ((const float*)(__attribute__((address_space(1))) const float*)a.in[(i) + zq])
    int phase = 0; bool dup_l0 = false; (void)dup_l0;
#ifndef PHMASK
#define PHMASK 0xFFF
#endif
#ifndef ATTN_BODY
#define ATTN_BODY attn_body3
#endif
#ifndef LIN_BODY
#define LIN_BODY lin_body3
#endif
#ifndef MIXMASK
#define MIXMASK 7
#endif
#ifndef MIXDUP
#define MIXDUP 0
#endif
#define MIX_DUP(n) (((MIXDUP) >> (n)) & 1)
#define MIX_EN(n) (((MIXMASK) >> (n)) & 1)
#ifndef DUPMASK
#define DUPMASK 0
#endif
#ifndef DUP0MASK
#define DUP0MASK 0
#endif
#define PH_DUP(n) ((((DUPMASK) >> (n)) & 1) + ((((DUP0MASK) >> (n)) & 1) && dup_l0))
#define PH_EN(n) (((PHMASK) >> (n)) & 1)
#define IN_PH() (a.ph_lo <= phase && phase < a.ph_hi)
#define END_PH() do { if (a.ph_lo <= phase && phase + 1 < a.ph_hi) { if (a.ph_lo < 0) grid.sync(); else { XcdBarrier xb2_ = xbar; asm volatile("" : "+s"(xb2_.bar), "+s"(xb2_.x)); xcd_barrier(xb2_); } } ++phase; } while (0)

#define CONVERT_ITEMS(lo_, hi_, w0_, nw_) do { float* scr_ = (float*)lds + wid * 4096; \
    for (int it_ = (lo_) + (w0_); it_ < (hi_); it_ += (nw_)) { const int cl_ = it_ / 24576; int r_ = it_ - cl_ * 24576; \
        if (r_ < 5632) { transpose_item(INP(I_WIN) + (size_t)cl_ * DM * DIN, DM, DIN, 176, WIN_T + (size_t)cl_ * DINP * DM, 0, scr_, r_, lane); continue; } r_ -= 5632; \
        if (r_ < 2048) { transpose_item(INP(I_WOUT) + (size_t)cl_ * DM * DM, DM, DM, 64, WOUT_T + (size_t)cl_ * DM * DM, 0, scr_, r_, lane); continue; } r_ -= 2048; \
        if (r_ < 5632) { transpose_item(INP(I_WGATE) + (size_t)cl_ * DM * DFF, DM, DFF, 176, WGU_T + (size_t)cl_ * 2 * DFF * DM, 1, scr_, r_, lane); continue; } r_ -= 5632; \
        if (r_ < 5632) { transpose_item(INP(I_WUP) + (size_t)cl_ * DM * DFF, DM, DFF, 176, WGU_T + (size_t)cl_ * 2 * DFF * DM, 2, scr_, r_, lane); continue; } r_ -= 5632; \
        transpose_item(INP(I_WDOWN) + (size_t)cl_ * DFF * DM, DFF, DM, 64, WD_T + (size_t)cl_ * DM * DFF, 0, scr_, r_, lane); } } while (0)
#define GEMV_ITEMS(lo_, hi_, b0_, nbk_) do { float* sl = (float*)lds; for (int it = (lo_) + (b0_); it < (hi_); it += (nbk_)) { \
            const int l = it / 384, r2 = it - l * 384, kc = r2 / 24, cb = r2 - kc * 24; \
            for (int i = tid; i < 9 * 128; i += 512) { const int r = i >> 7, k = i & 127; const float cv = r < 8 ? INP(I_C)[r * DM + kc * 128 + k] : INP(I_CCTX)[kc * 128 + k]; sl[i] = silu_acc(cv); } \
            __syncthreads(); \
            const int n = cb * 512 + tid; const float* wp = INP(I_WMOD) + ((size_t)l * DM + kc * 128) * 12288 + n; \
            float acc[9]; \
    _Pragma("unroll") \
            for (int r = 0; r < 9; ++r) acc[r] = 0.f; \
            for (int k0 = 0; k0 < 128; k0 += 16) { float wv[16]; \
    _Pragma("unroll") \
                for (int k = 0; k < 16; ++k) wv[k] = __builtin_nontemporal_load(wp + (size_t)(k0 + k) * 12288); \
    _Pragma("unroll") \
                for (int k = 0; k < 16; ++k) { \
    _Pragma("unroll") \
                    for (int r = 0; r < 9; ++r) acc[r] += sl[r * 128 + k0 + k] * wv[k]; } } \
    _Pragma("unroll") \
            for (int r = 0; r < 9; ++r) MODP[((size_t)(kc * 2 + l) * 9 + r) * 12288 + n] = acc[r]; \
            __syncthreads(); \
    } } while (0)
#define MOD_REDUCE(lo_, hi_) do { \
        for (long i = (lo_) + gtid; i < (hi_); i += GT) { const int l = (int)(i / (9 * 12288)), rem = (int)(i - (long)l * 9 * 12288), r = rem / 12288, n = rem - r * 12288; \
            float s = INP(I_BMOD)[l * 12288 + n]; \
    _Pragma("unroll") \
            for (int kc = 0; kc < 16; ++kc) s += MODP[((size_t)(kc * 2 + l) * 9 + r) * 12288 + n]; \
            const int ch_ = n >> 11, k_ = n & 2047; \
            if (ch_ == 1) s = (1.0f + s) * INP(I_PREMIX)[l * DM + k_]; else if (ch_ == 2) s = s * INP(I_POSTMIX)[l * DM + k_]; \
            else if (ch_ == 4) s = (1.0f + s) * INP(I_PREFFN)[l * DM + k_]; else if (ch_ == 5) s = s * INP(I_POSTFFN)[l * DM + k_]; \
            MOD[i] = s; } \
    } while (0)
    if (PH_EN(0) && IN_PH()) for (int rep_ = 0; rep_ < 1 + PH_DUP(0); ++rep_) { if (rep_) __syncthreads(); PH_VARS();
        CONVERT_ITEMS(0, 5632, gw, NGW); CONVERT_ITEMS(TAILCUT, 49152, gw, NGW);
        __syncthreads();
        GEMV_ITEMS(0, 384, (int)blockIdx.x, G);
        for (long i = gtid; i < 2048; i += GT) { const int pos = (int)i >> 5, f = (int)i & 31; const float inv = powf(10000.f, -(float)f * (1.f / 32.f)); const float ang = (float)pos * inv;
            ROPE[2 * i] = cosf(ang); ROPE[2 * i + 1] = sinf(ang); }
    }
    END_PH();
    if (PH_EN(1) && IN_PH()) for (int rep_ = 0; rep_ < 1 + PH_DUP(1); ++rep_) { if (rep_) __syncthreads(); PH_VARS();
        MOD_REDUCE(0, 9 * 12288);
    }
    END_PH();
#ifdef EXTRA_SYNCS
    for (int es_ = 0; es_ < EXTRA_SYNCS; ++es_) xcd_barrier(xbar);
#endif
    if (PH_EN(2) && IN_PH()) for (int rep_ = 0; rep_ < 1 + PH_DUP(2); ++rep_) { if (rep_) __syncthreads(); PH_VARS();
        for (int row = gw; row < MTOT; row += NGW) {
            const float* xin = row < MLAT ? INP(I_X) + (size_t)row * DM : INP(I_CTX) + (size_t)(row - MLAT) * DM;
            row_op<false, false>(xin, nullptr, nullptr, nullptr, nullptr, nullptr, mod_vec(MOD, 0, row, 1), mod_vec(MOD, 0, row, 0), ACT + (size_t)row * DM, lane);
        }
    }
    END_PH();

    for (int l_it = 0; l_it < 2; ++l_it) {
        int l = l_it; asm volatile("" : "+s"(l));
        const int Mcur = (l == 1) ? MLAT : MTOT; dup_l0 = (l == 0);
        if (PH_EN(3) && IN_PH()) for (int rep_ = 0; rep_ < 1 + PH_DUP(3); ++rep_) { if (rep_) __syncthreads(); PH_VARS();
            pg8::Gemm g{ACT, WIN_T + (size_t)l * DINP * DM, MTOT, DINP, DM}; pg8::InprojOrder S; S.init(G, (int)blockIdx.x, l);
            pg8::EpiStore E{PROJ, DINP, DT, C_DT / 256};
            pg8::gemm_phase<pg8::EpiStore, pg8::InprojOrder, true, true>((PG8_LAS unsigned char*)lds, g, S, E);
            if (l == 0) {
                const int nb_ = (1584 - 6 * G > 0 && 1584 - 6 * G < G) ? 1584 - 6 * G : 0;
                if (TAILCUT > 5632 && (int)blockIdx.x >= nb_) CONVERT_ITEMS(5632, (TAILCUT < 18944 ? TAILCUT : 18944), ((int)blockIdx.x - nb_) * 8 + wid, (G - nb_) * 8);
            }
        }
        END_PH();
        if (PH_EN(4) && IN_PH()) for (int rep_ = 0; rep_ < 1 + PH_DUP(4); ++rep_) { if (rep_) __syncthreads(); PH_VARS();
            const float* qg = INP(I_QG) + l * 128; const float* kg = INP(I_KG) + l * 128;
            if (rep_ == 0) for (int row = gw; row < MTOT; row += 3 * NGW) {
                if (row + 2 * NGW < MTOT) { const int rows[3] = {row, row + NGW, row + 2 * NGW}; prep_rows<3>(PROJ, rows, ROPE, qg, kg, lane); }
                else { for (int r2 = row; r2 < MTOT; r2 += NGW) { const int rows[1] = {r2}; prep_rows<1>(PROJ, rows, ROPE, qg, kg, lane); } } }
            const float* cw = INP(I_CONVW) + (size_t)l * 5 * CVW; const float* cbias = INP(I_CONVB) + (size_t)l * CVW;
            for (int u = gw; u < (MTOT / 32) * 10; u += NGW) {
                const int rc = u / 10, cgp = u - rc * 10, r0 = rc * 32, ch = cgp * 128 + 2 * lane;
                int S0, S1; if (r0 < MLAT) { S0 = r0 & ~(SEQ - 1); S1 = S0 + SEQ; } else { S0 = MLAT + ((r0 - MLAT) & ~(CTXL - 1)); S1 = S0 + CTXL; }
                float w0[5], w1[5];
#pragma unroll
                for (int k = 0; k < 5; ++k) { w0[k] = cw[k * CVW + ch]; w1[k] = cw[k * CVW + ch + 1]; }
                const float b0 = cbias[ch], b1 = cbias[ch + 1];
                unsigned uw[36];
#pragma unroll
                for (int i = 0; i < 36; ++i) uw[i] = ld_u(PROJ, r0 - 2 + i, S0, S1, ch);
#pragma unroll
                for (int i = 0; i < 32; ++i) { const int row = r0 + i;
                    const float y0 = b0 + w0[0] * bflo(uw[i]) + w0[1] * bflo(uw[i + 1]) + w0[2] * bflo(uw[i + 2]) + w0[3] * bflo(uw[i + 3]) + w0[4] * bflo(uw[i + 4]);
                    const float y1 = b1 + w1[0] * bfhi(uw[i]) + w1[1] * bfhi(uw[i + 1]) + w1[2] * bfhi(uw[i + 2]) + w1[3] * bfhi(uw[i + 3]) + w1[4] * bfhi(uw[i + 4]);
                    *(unsigned*)(CV + (size_t)row * CVW + ch) = pkbf(pg8::silu_f(y0), pg8::silu_f(y1)); }
            }
            for (int u = gw; u < NBATCH * 24; u += NGW) {
                const int b = u / 24, rem = u - b * 24, dir = rem / 12, h = rem - dir * 12;
                const float bias = INP(dir ? I_DTBB : I_DTBF)[l * 12 + h]; const float A = expf(INP(dir ? I_ALB : I_ALF)[l * 12 + h]);
                float* mq = MASK + ((size_t)(b * 16 + h) * 4 + 2 * dir) * NKEY; float* mkk = mq + NKEY;
                float la[36], ldt[36];
                RSBAR();
#pragma unroll
                for (int i = 0; i < 36; ++i) { const int p = i * 64 + lane; int n = p; if (dir) { const int bp = 2303 - p; n = bp < SEQ ? CTXL + bp : bp - SEQ; }
                    const int row = n < CTXL ? MLAT + b * CTXL + n : b * SEQ + n - CTXL; la[i] = DT[(size_t)row * 24 + dir * 12 + h]; }
                RSBAR();
#pragma unroll
                for (int i = 0; i < 36; ++i) { const float dt = softplus_hw(la[i] + bias); la[i] = -dt * A; ldt[i] = __builtin_amdgcn_logf(dt); }
                float carry = 0.f;
#pragma unroll
                for (int i = 0; i < 36; ++i) { float inc = la[i];
#pragma unroll
                    for (int o = 1; o < 64; o <<= 1) { const float v = __shfl_up(inc, o); if (lane >= o) inc += v; }
                    const float run = carry + inc; carry += __shfl(inc, 63);
                    const int p = i * 64 + lane; int n = p; if (dir) { const int bp = 2303 - p; n = bp < SEQ ? CTXL + bp : bp - SEQ; }
                    mq[n] = run * LOG2E; mkk[n] = run * LOG2E - ldt[i]; }
            }
            for (long i = gtid; i < (long)NBATCH * 4 * NKEY; i += GT) { const int b = (int)(i / (4 * NKEY)), rem = (int)(i - (long)b * 4 * NKEY), h = rem / NKEY, n = rem - h * NKEY;
                const float lf = log1pf(-exp2f(INP(I_RDF)[l * 4 + h])), lb = log1pf(-exp2f(INP(I_RDB)[l * 4 + h]));
                const float vf = lf * (float)n * LOG2E, vb = lb * (float)(n < CTXL ? CTXL - n : 2560 - n) * LOG2E;
                float* m = MASK + ((size_t)(b * 16 + 12 + h) * 4) * NKEY; m[n] = vf; m[NKEY + n] = vf; m[2 * NKEY + n] = vb; m[3 * NKEY + n] = vb; }
        }
        END_PH();
        if (PH_EN(5) && IN_PH()) for (int rep_ = 0; rep_ < 1 + PH_DUP(5); ++rep_) { if (rep_) __syncthreads(); PH_VARS();
            const int NU = 1024 + (l == 0 ? 128 : 0);
            const int vcu = (G % 8 == 0) ? ((int)blockIdx.x % 8) * (G / 8) + (int)blockIdx.x / 8 : (int)blockIdx.x;
            for (int mrep_ = 0; mrep_ < 1 + MIX_DUP(0); ++mrep_) if (MIX_EN(0)) for (int u = vcu; u < NU; u += G) {
                int b, job, qrow0, ctx_row0, lat_row0, NT, qn0, tq0; bool latq;
                if (u < 1024) { const int r = u >> 8, k = u & 255, qblk = k & 7, kb = k >> 3; b = kb & 7; job = r * 4 + (kb >> 3); qrow0 = b * SEQ + qblk * 256; NT = 36; latq = true; qn0 = CTXL + qblk * 256; tq0 = qblk * 256; }
                else { const int uu = u - 1024; b = uu & 7; job = uu >> 3; qrow0 = MLAT + b * CTXL; NT = 4; latq = false; qn0 = 0; tq0 = 0; }
                ctx_row0 = MLAT + b * CTXL; lat_row0 = b * SEQ;
                if (job >= 6) continue;
                __syncthreads();
                const int tid_u = otid(), lane_u = tid_u & 63, wid = __builtin_amdgcn_readfirstlane(tid_u >> 6), hi = lane_u >> 5, r32 = lane_u & 31; (void)hi; (void)r32; (void)wid;
                    const int h = job, kvh = h / 3;
                    mx::ATTN_BODY(PROJ + (size_t)qrow0 * DINP + C_AQ + h * 128, PROJ + C_AK + kvh * 128, PROJ + C_AV + kvh * 128, DINP, ctx_row0, lat_row0, NT,
                                  ACT + (size_t)qrow0 * DM + h * 128, DM, (char*)lds);
            }
            for (int mrep_ = 0; mrep_ < 1 + MIX_DUP(1); ++mrep_) if (MIX_EN(1)) for (int u = vcu; u < NU; u += G) {
                int b, job, qrow0, ctx_row0, lat_row0, NT, qn0, tq0; bool latq;
                if (u < 1024) { const int r = u >> 8, k = u & 255, qblk = k & 7, kb = k >> 3; b = kb & 7; job = r * 4 + (kb >> 3); qrow0 = b * SEQ + qblk * 256; NT = 36; latq = true; qn0 = CTXL + qblk * 256; tq0 = qblk * 256; }
                else { const int uu = u - 1024; b = uu & 7; job = uu >> 3; qrow0 = MLAT + b * CTXL; NT = 4; latq = false; qn0 = 0; tq0 = 0; }
                ctx_row0 = MLAT + b * CTXL; lat_row0 = b * SEQ;
                if (job < 6 || job >= 10) continue;
                __syncthreads();
                const int tid_u = otid(), lane_u = tid_u & 63, wid = __builtin_amdgcn_readfirstlane(tid_u >> 6), hi = lane_u >> 5, r32 = lane_u & 31; (void)hi; (void)r32; (void)wid;
                    const int h = job - 6; mx::f32x16 o[4];
                    mx::LIN_BODY<1>(PROJ + (size_t)qrow0 * DINP + C_RQ + h * 128, PROJ + C_RK + h * 128, PROJ + C_RV + h * 128, DINP, ctx_row0, lat_row0, NT,
                                    MASK + ((size_t)(b * 16 + 12 + h) * 4) * NKEY, qn0, tq0, latq, o, (char*)lds);
                    float ss[16];
#pragma unroll
                    for (int r = 0; r < 16; ++r) { float s = 0.f;
#pragma unroll
                        for (int d0 = 0; d0 < 4; ++d0) s += o[d0][r] * o[d0][r];
#pragma unroll
                        for (int of = 1; of < 32; of <<= 1) s += __shfl_xor(s, of);
                        ss[r] = rsqrtf(s * (1.f / 128.f) + EPSN); }
                    unsigned short gv[16][4];
                    mx::SBAR_();
#pragma unroll
                    for (int r = 0; r < 16; ++r) { const size_t row = (size_t)qrow0 + wid * 32 + mx::crow(r, hi);
#pragma unroll
                        for (int d0 = 0; d0 < 4; ++d0) gv[r][d0] = __builtin_nontemporal_load(PROJ + row * DINP + C_RG + h * 128 + 32 * d0 + r32); }
                    mx::SBAR_();
#pragma unroll
                    for (int r = 0; r < 16; ++r) { const size_t row = (size_t)qrow0 + wid * 32 + mx::crow(r, hi);
#pragma unroll
                        for (int d0 = 0; d0 < 4; ++d0) ACT[row * DM + 768 + h * 128 + 32 * d0 + r32] = mx::f2bf(o[d0][r] * ss[r] * pg8::silu_f(mx::bf2f(gv[r][d0]))); }
            }
            for (int mrep_ = 0; mrep_ < 1 + MIX_DUP(2); ++mrep_) if (MIX_EN(2)) for (int u = vcu; u < NU; u += G) {
                int b, job, qrow0, ctx_row0, lat_row0, NT, qn0, tq0; bool latq;
                if (u < 1024) { const int r = u >> 8, k = u & 255, qblk = k & 7, kb = k >> 3; b = kb & 7; job = r * 4 + (kb >> 3); qrow0 = b * SEQ + qblk * 256; NT = 36; latq = true; qn0 = CTXL + qblk * 256; tq0 = qblk * 256; }
                else { const int uu = u - 1024; b = uu & 7; job = uu >> 3; qrow0 = MLAT + b * CTXL; NT = 4; latq = false; qn0 = 0; tq0 = 0; }
                ctx_row0 = MLAT + b * CTXL; lat_row0 = b * SEQ;
                if (job < 10) continue;
                __syncthreads();
                const int tid_u = otid(), lane_u = tid_u & 63, wid = __builtin_amdgcn_readfirstlane(tid_u >> 6), hi = lane_u >> 5, r32 = lane_u & 31; (void)hi; (void)r32; (void)wid;
                    const int p = job - 10, g = p / 3; mx::f32x16 o[4];
                    mx::LIN_BODY<2>(CV + (size_t)qrow0 * CVW + 1024 + g * 128, CV + 768 + g * 128, CV + p * 128, CVW, ctx_row0, lat_row0, NT,
                                    MASK + ((size_t)(b * 16 + 2 * p) * 4) * NKEY, qn0, tq0, latq, o, (char*)lds);
                    const float ds0 = INP(I_DSKIP)[l * 12 + 2 * p], ds1 = INP(I_DSKIP)[l * 12 + 2 * p + 1];
                    unsigned short xv[16][4], zv[16][4];
                    mx::SBAR_();
#pragma unroll
                    for (int r = 0; r < 16; ++r) { const size_t row = (size_t)qrow0 + wid * 32 + mx::crow(r, hi);
#pragma unroll
                        for (int d0 = 0; d0 < 4; ++d0) { xv[r][d0] = CV[row * CVW + p * 128 + 32 * d0 + r32]; zv[r][d0] = __builtin_nontemporal_load(PROJ + row * DINP + C_Z + p * 128 + 32 * d0 + r32); } }
                    mx::SBAR_();
#pragma unroll
                    for (int r = 0; r < 16; ++r) { const size_t row = (size_t)qrow0 + wid * 32 + mx::crow(r, hi);
#pragma unroll
                        for (int d0 = 0; d0 < 4; ++d0) ACT[row * DM + 1280 + p * 128 + 32 * d0 + r32] = mx::f2bf((o[d0][r] + (d0 < 2 ? ds0 : ds1) * mx::bf2f(xv[r][d0])) * pg8::silu_f(mx::bf2f(zv[r][d0]))); }
            }
        }
        END_PH();
        if (PH_EN(6) && IN_PH()) for (int rep_ = 0; rep_ < 1 + PH_DUP(6); ++rep_) { if (rep_) __syncthreads(); PH_VARS();
            const float* sg = INP(I_SSDG) + (size_t)l * 768;
            f32x4 gv[3];
#pragma unroll
            for (int j = 0; j < 3; ++j) gv[j] = *(const f32x4*)(sg + j * 256 + lane * 4);
            for (int row0 = gw; row0 < Mcur; row0 += 3 * NGW) {
                u32x2 w[3][3];
                RSBAR();
#pragma unroll
                for (int q = 0; q < 3; ++q) { const int row = row0 + q * NGW;
#pragma unroll
                    for (int j = 0; j < 3; ++j) w[q][j] = (row < Mcur) ? *(const u32x2*)(ACT + (size_t)row * DM + 1280 + j * 256 + lane * 4) : (u32x2){0u, 0u}; }
                RSBAR();
#pragma unroll
                for (int q = 0; q < 3; ++q) { const int row = row0 + q * NGW; f32x4 v[3]; float ss = 0.f;
#pragma unroll
                    for (int j = 0; j < 3; ++j) { v[j] = (f32x4){bflo(w[q][j].x), bfhi(w[q][j].x), bflo(w[q][j].y), bfhi(w[q][j].y)};
                        ss += (v[j].x * v[j].x + v[j].y * v[j].y) + (v[j].z * v[j].z + v[j].w * v[j].w); }
                    const float rstd = rsqrtf(wave_sum(ss) * (1.f / 768.f) + EPSN);
                    if (row < Mcur) {
#pragma unroll
                        for (int j = 0; j < 3; ++j) { const f32x4 y = (v[j] * rstd) * gv[j]; u32x2 o; o.x = pkbf(y.x, y.y); o.y = pkbf(y.z, y.w);
                            *(u32x2*)(ACT + (size_t)row * DM + 1280 + j * 256 + lane * 4) = o; } } }
            }
        }
        END_PH();
        if (PH_EN(7) && IN_PH()) for (int rep_ = 0; rep_ < 1 + PH_DUP(7); ++rep_) { if (rep_) __syncthreads(); PH_VARS();
            pg8::Gemm g{ACT, WOUT_T + (size_t)l * DM * DM, Mcur, DM, DM}; pg8::StaticOrder S; S.init(Mcur, DM, G, (int)blockIdx.x);
            pg8::EpiStore E{MF, DM, nullptr, -1};
            pg8::gemm_phase<pg8::EpiStore, pg8::StaticOrder, true, true>((PG8_LAS unsigned char*)lds, g, S, E);
            if (l == 0) {
                const int nb_ = (576 - 2 * G > 0 && 576 - 2 * G < G) ? 576 - 2 * G : 0;
                if (TAILCUT > 18944 && (int)blockIdx.x >= nb_) CONVERT_ITEMS(18944, (TAILCUT < 24576 ? TAILCUT : 24576), ((int)blockIdx.x - nb_) * 8 + wid, (G - nb_) * 8);
                if ((int)blockIdx.x >= nb_) { __syncthreads(); GEMV_ITEMS(384, 768, (int)blockIdx.x - nb_, G - nb_); }
            }
        }
        END_PH();
        if (PH_EN(8) && IN_PH()) for (int rep_ = 0; rep_ < 1 + PH_DUP(8); ++rep_) { if (rep_) __syncthreads(); PH_VARS();
            if (l == 0) MOD_REDUCE(9 * 12288, 2 * 9 * 12288);
            for (int row = gw; row < Mcur; row += NGW) {
                bf16_t* xb = XB + (size_t)row * DM;
                if (l == 0) { const float* xin = row < MLAT ? INP(I_X) + (size_t)row * DM : INP(I_CTX) + (size_t)(row - MLAT) * DM;
                    row_op<false, true>(xin, nullptr, MF + (size_t)row * DM, mod_vec(MOD, l, row, 2), nullptr, xb,
                                        mod_vec(MOD, l, row, 4), mod_vec(MOD, l, row, 3), ACT + (size_t)row * DM, lane); }
                else row_op<true, true>(nullptr, xb, MF + (size_t)row * DM, mod_vec(MOD, l, row, 2), nullptr, xb,
                                        mod_vec(MOD, l, row, 4), mod_vec(MOD, l, row, 3), ACT + (size_t)row * DM, lane);
            }
        }
        END_PH();
        if (PH_EN(9) && IN_PH()) for (int rep_ = 0; rep_ < 1 + PH_DUP(9); ++rep_) { if (rep_) __syncthreads(); PH_VARS();
            pg8::Gemm g{ACT, WGU_T + (size_t)l * 2 * DFF * DM, Mcur, 2 * DFF, DM}; pg8::StaticOrder S; S.init(Mcur, 2 * DFF, G, (int)blockIdx.x);
            pg8::EpiSwiglu E{PROJ, DFF};
            pg8::gemm_phase<pg8::EpiSwiglu, pg8::StaticOrder, true, true>((PG8_LAS unsigned char*)lds, g, S, E);
        }
        END_PH();
        if (PH_EN(10) && IN_PH()) for (int rep_ = 0; rep_ < 1 + PH_DUP(10); ++rep_) { if (rep_) __syncthreads(); PH_VARS();
            pg8::Gemm g{PROJ, WD_T + (size_t)l * DM * DFF, Mcur, DM, DFF}; pg8::StaticOrder S; S.init(Mcur, DM, G, (int)blockIdx.x);
            pg8::EpiStore E{MF, DM, nullptr, -1};
            pg8::gemm_phase<pg8::EpiStore, pg8::StaticOrder, true, true>((PG8_LAS unsigned char*)lds, g, S, E);
            if (l == 0) {
                const int nb_ = (576 - 2 * G > 0 && 576 - 2 * G < G) ? 576 - 2 * G : 0;
                if (TAILCUT > 24576 && (int)blockIdx.x >= nb_) CONVERT_ITEMS(24576, TAILCUT, ((int)blockIdx.x - nb_) * 8 + wid, (G - nb_) * 8);
            }
        }
        END_PH();
        if (PH_EN(11) && IN_PH()) for (int rep_ = 0; rep_ < 1 + PH_DUP(11); ++rep_) { if (rep_) __syncthreads(); PH_VARS();
            for (int row = gw; row < Mcur; row += NGW) {
                bf16_t* xb = XB + (size_t)row * DM;
                if (l == 0) row_op<true, true>(nullptr, xb, MF + (size_t)row * DM, mod_vec(MOD, l, row, 5), nullptr, xb,
                                               mod_vec(MOD, 1, row, 1), mod_vec(MOD, 1, row, 0), ACT + (size_t)row * DM, lane);
                else row_op<true, false>(nullptr, xb, MF + (size_t)row * DM, mod_vec(MOD, l, row, 5), OUTP + (size_t)row * DM, nullptr,
                                         nullptr, nullptr, nullptr, lane);
            }
        }
        END_PH();
    }
#undef IN_PH
#undef END_PH
}

extern "C" void kernel_launch(void* const* d_in, const int* in_sizes, int n_in, void* d_out, int out_size, void* d_ws, size_t ws_size, hipStream_t stream) {
    static int grid = 0;
    if (grid == 0) {
        if (n_in != N_IN || out_size != MLAT * DM || ws_size < WS_END) { fprintf(stderr, "kernel_launch: unexpected shapes: n_in %d out %d ws %zu (need %zu)\n", n_in, out_size, ws_size, (size_t)WS_END); grid = -1; return; }
        int dev = 0, cus = 0, per_cu = 0;
        if (hipGetDevice(&dev) != hipSuccess || hipDeviceGetAttribute(&cus, hipDeviceAttributeMultiprocessorCount, dev) != hipSuccess) { grid = -1; return; }
        if (hipFuncSetAttribute((const void*)hybrid_fwd, hipFuncAttributeMaxDynamicSharedMemorySize, LDS_BYTES) != hipSuccess) { fprintf(stderr, "kernel_launch: hipFuncSetAttribute failed\n"); grid = -1; return; }
        if (hipOccupancyMaxActiveBlocksPerMultiprocessor(&per_cu, (const void*)hybrid_fwd, 512, LDS_BYTES) != hipSuccess || per_cu < 1) { fprintf(stderr, "kernel_launch: occupancy query gave %d\n", per_cu); per_cu = 1; }
        (void)hipGetLastError();
        grid = cus * 1;
        fprintf(stderr, "kernel_launch: grid %d (cus %d, per_cu %d), ws %zu\n", grid, cus, per_cu, ws_size);
    }
    if (grid < 0) return;
    if (hipMemsetAsync((char*)d_ws + WS_BAR, 0, XCD_BAR_WORDS * 4, stream) != hipSuccess) { fprintf(stderr, "kernel_launch: memset failed\n"); return; }
    KArgs a{};
    for (int i = 0; i < N_IN; ++i) a.in[i] = (const float*)d_in[i];
    a.out = (float*)d_out; a.ws = (unsigned char*)d_ws;
#if MK_PER_PHASE
    for (int ph = 0; ph < NPHASE; ++ph) { a.ph_lo = ph; a.ph_hi = ph + 1; hipLaunchKernelGGL(hybrid_fwd, dim3(grid), dim3(512), LDS_BYTES, stream, a); }
#else
#ifndef MK_PH_HI
#define MK_PH_HI NPHASE
#endif
    a.ph_lo = 0; a.ph_hi = MK_PH_HI;
    void* args[] = {&a};
    hipError_t e = hipLaunchCooperativeKernel((void*)hybrid_fwd, dim3(grid), dim3(512), args, LDS_BYTES, stream);
    if (e != hipSuccess) fprintf(stderr, "kernel_launch: cooperative launch failed: %s (grid %d)\n", hipGetErrorString(e), grid);
#endif
}
```
